# Optimizing an MI355X kernel written in HIP

```python
import jax, jax.numpy as jnp
from jax import lax
import numpy as np

D_MODEL = 1024
BATCH = 16
SEQ = 4096
DEPTH = 4

D_FF = 2816
MLA_HEADS = 8
Q_LORA = 256
KV_LORA = 128
QK_NOPE = 64
QK_ROPE = 32
V_HEAD = 64
QK_HEAD = QK_NOPE + QK_ROPE
MLA_WIDTH = MLA_HEADS * V_HEAD
ROPE_THETA = 10000.0
Q_BLOCK = 128
POOL_WINDOWS = (2, 4, 8, 16)
POOL_GROUPS = len(POOL_WINDOWS)
POOL_WIDTH = D_MODEL - MLA_WIDTH
POOL_GROUP_DIM = POOL_WIDTH // POOL_GROUPS
EVEN_IN = Q_LORA + KV_LORA + QK_ROPE + POOL_WIDTH
CHUNK = 128
SG_GROUPS = 4
SG_WIDTH = D_MODEL
SG_GROUP_DIM = SG_WIDTH // SG_GROUPS
EPS = 1e-6
N_EVEN = (DEPTH + 1) // 2
N_ODD = DEPTH // 2
MAX_POS_OFFSET = 4096

kernel_name = "hybrid_mla_pool_gmlp_macaron"


def _rmsnorm(x, g):
    xf = x.astype(jnp.float32)
    y = xf * lax.rsqrt(jnp.mean(xf * xf, axis=-1, keepdims=True) + EPS)
    return (y * g.astype(jnp.float32)).astype(x.dtype)


def _swiglu(x, w_gate, w_up, w_down):
    return (jax.nn.silu(x @ w_gate) * (x @ w_up)) @ w_down


def _rope_tables(positions):
    inv_freq = ROPE_THETA ** (-jnp.arange(0, QK_ROPE, 2, dtype=jnp.float32) / QK_ROPE)
    ang = positions.astype(jnp.float32)[..., None] * inv_freq
    return jnp.cos(ang)[:, :, None, :], jnp.sin(ang)[:, :, None, :]


def _rope(x, cos, sin):
    xf = x.astype(jnp.float32)
    x1, x2 = xf[..., : QK_ROPE // 2], xf[..., QK_ROPE // 2:]
    return jnp.concatenate([x1 * cos - x2 * sin, x1 * sin + x2 * cos], axis=-1).astype(x.dtype)


def _causal_attention(q, k, v):
    B, S, H, D = q.shape
    nb = S // Q_BLOCK
    scale = D ** -0.5
    qb = q.reshape(B, nb, Q_BLOCK, H, D).transpose(1, 0, 2, 3, 4)
    k_pos = jnp.arange(S)

    def block(args):
        q_blk, start = args
        s = jnp.einsum('bqhd,bkhd->bhqk', q_blk, k, preferred_element_type=jnp.float32) * scale
        q_pos = start + jnp.arange(Q_BLOCK)
        s = jnp.where(k_pos[None, :] <= q_pos[:, None], s, -jnp.inf)
        p = jax.nn.softmax(s, axis=-1)
        return jnp.einsum('bhqk,bkhd->bqhd', p.astype(v.dtype), v)

    out = lax.map(block, (qb, jnp.arange(nb) * Q_BLOCK))
    return out.transpose(1, 0, 2, 3, 4).reshape(B, S, H, v.shape[-1])


def _multiscale_pool(p, pool_w, pool_scale):
    B, S, _ = p.shape
    pg = p.reshape(B, S, POOL_GROUPS, POOL_GROUP_DIM).astype(jnp.float32)
    cs = jnp.concatenate([jnp.zeros((B, 1, POOL_GROUPS, POOL_GROUP_DIM), jnp.float32),
                          jnp.cumsum(pg, axis=1)], axis=1)
    t = jnp.arange(S)
    outs = []
    for g, w in enumerate(POOL_WINDOWS):
        upper = cs[:, 1:, g]
        lower = jnp.concatenate([jnp.zeros((B, w - 1, POOL_GROUP_DIM), jnp.float32),
                                 cs[:, : S - w + 1, g]], axis=1)
        count = jnp.minimum(t + 1, w).astype(jnp.float32)[None, :, None]
        outs.append((upper - lower) / count - pg[:, :, g])
    pooled = jnp.stack(outs, axis=2).astype(p.dtype)
    mixed = jnp.einsum('bsgc,gcd->bsgd', pooled, pool_w)
    return mixed.reshape(B, S, POOL_WIDTH) * pool_scale


def _mla_pool_mixer(hn, cos, sin, w_in, q_a_g, kv_a_g, w_uq, w_ukv, q_g, k_g,
                    pool_w, pool_scale, w_out):
    B, S, _ = hn.shape
    proj = hn @ w_in
    c_q, c_kv, k_pe, p = jnp.split(
        proj, [Q_LORA, Q_LORA + KV_LORA, Q_LORA + KV_LORA + QK_ROPE], axis=-1)
    q = (_rmsnorm(c_q, q_a_g) @ w_uq).reshape(B, S, MLA_HEADS, QK_HEAD)
    kv = (_rmsnorm(c_kv, kv_a_g) @ w_ukv).reshape(B, S, MLA_HEADS, QK_NOPE + V_HEAD)
    k_nope, v = kv[..., :QK_NOPE], kv[..., QK_NOPE:]
    k = jnp.concatenate(
        [k_nope, jnp.broadcast_to(k_pe[:, :, None, :], (B, S, MLA_HEADS, QK_ROPE))], axis=-1)
    q = _rmsnorm(q, q_g)
    k = _rmsnorm(k, k_g)
    q = jnp.concatenate([q[..., :QK_NOPE], _rope(q[..., QK_NOPE:], cos, sin)], axis=-1)
    k = jnp.concatenate([k[..., :QK_NOPE], _rope(k[..., QK_NOPE:], cos, sin)], axis=-1)
    attn = _causal_attention(q, k, v).reshape(B, S, MLA_WIDTH)
    pooled = _multiscale_pool(p, pool_w, pool_scale)
    return jnp.concatenate([attn, pooled], axis=-1) @ w_out


def _spatial_gating_mixer(hn, w_in, sg_norm_g, sg_w, sg_b, w_out):
    B, S, _ = hn.shape
    uv = jax.nn.gelu(hn @ w_in)
    u, v = jnp.split(uv, 2, axis=-1)
    v = _rmsnorm(v, sg_norm_g)
    vc = v.reshape(B, S // CHUNK, CHUNK, SG_GROUPS, SG_GROUP_DIM)
    w = sg_w * jnp.tril(jnp.ones((CHUNK, CHUNK), sg_w.dtype))
    mixed = jnp.einsum('gts,bnsgc->bntgc', w, vc) + sg_b.T[None, None, :, :, None]
    return (u * mixed.reshape(B, S, SG_WIDTH)) @ w_out


def setup_inputs(seed: int = 0) -> dict:
    key = jax.random.key(seed)
    ks = jax.random.split(key, 24)
    f32 = jnp.float32

    def nrm(k, shape, fan_in):
        return jax.random.normal(k, shape, f32) * (fan_in ** -0.5)

    def gain(k, shape):
        return 1.0 + 0.02 * jax.random.normal(k, shape, f32)

    x = jax.random.normal(ks[0], (BATCH, SEQ, D_MODEL), f32)
    offset = jax.random.randint(ks[1], (BATCH, 1), 0, MAX_POS_OFFSET, dtype=jnp.int32)
    positions = (offset + jnp.arange(SEQ, dtype=jnp.int32)[None, :]).astype(jnp.int32)
    return {
        "x": x,
        "positions": positions,
        "ffn_norm": gain(ks[2], (DEPTH, 2, D_MODEL)),
        "ffn_w_gate": nrm(ks[3], (DEPTH, 2, D_MODEL, D_FF), D_MODEL),
        "ffn_w_up": nrm(ks[4], (DEPTH, 2, D_MODEL, D_FF), D_MODEL),
        "ffn_w_down": nrm(ks[5], (DEPTH, 2, D_FF, D_MODEL), D_FF),
        "mix_norm": gain(ks[6], (DEPTH, D_MODEL)),
        "even_w_in": nrm(ks[7], (N_EVEN, D_MODEL, EVEN_IN), D_MODEL),
        "q_a_norm": gain(ks[8], (N_EVEN, Q_LORA)),
        "kv_a_norm": gain(ks[9], (N_EVEN, KV_LORA)),
        "w_uq": nrm(ks[10], (N_EVEN, Q_LORA, MLA_HEADS * QK_HEAD), Q_LORA),
        "w_ukv": nrm(ks[11], (N_EVEN, KV_LORA, MLA_HEADS * (QK_NOPE + V_HEAD)), KV_LORA),
        "q_norm": gain(ks[12], (N_EVEN, QK_HEAD)),
        "k_norm": gain(ks[13], (N_EVEN, QK_HEAD)),
        "pool_w": nrm(ks[14], (N_EVEN, POOL_GROUPS, POOL_GROUP_DIM, POOL_GROUP_DIM), POOL_GROUP_DIM),
        "pool_scale": gain(ks[15], (N_EVEN, POOL_WIDTH)),
        "even_w_out": nrm(ks[16], (N_EVEN, D_MODEL, D_MODEL), D_MODEL),
        "odd_w_in": nrm(ks[17], (N_ODD, D_MODEL, 2 * SG_WIDTH), D_MODEL),
        "sg_norm": gain(ks[18], (N_ODD, SG_WIDTH)),
        "sg_w": nrm(ks[19], (N_ODD, SG_GROUPS, CHUNK, CHUNK), CHUNK),
        "sg_b": gain(ks[20], (N_ODD, SG_GROUPS, CHUNK)),
        "odd_w_out": nrm(ks[21], (N_ODD, SG_WIDTH, D_MODEL), SG_WIDTH),
    }


def reference(x, positions, ffn_norm, ffn_w_gate, ffn_w_up, ffn_w_down, mix_norm,
              even_w_in, q_a_norm, kv_a_norm, w_uq, w_ukv, q_norm, k_norm,
              pool_w, pool_scale, even_w_out, odd_w_in, sg_norm, sg_w, sg_b, odd_w_out):
    cos, sin = _rope_tables(positions)
    h = x
    for layer in range(DEPTH):
        h = h + 0.5 * _swiglu(_rmsnorm(h, ffn_norm[layer, 0]), ffn_w_gate[layer, 0],
                              ffn_w_up[layer, 0], ffn_w_down[layer, 0])
        hn = _rmsnorm(h, mix_norm[layer])
        i = layer // 2
        if layer % 2 == 0:
            h = h + _mla_pool_mixer(hn, cos, sin, even_w_in[i], q_a_norm[i], kv_a_norm[i],
                                    w_uq[i], w_ukv[i], q_norm[i], k_norm[i],
                                    pool_w[i], pool_scale[i], even_w_out[i])
        else:
            h = h + _spatial_gating_mixer(hn, odd_w_in[i], sg_norm[i], sg_w[i], sg_b[i],
                                          odd_w_out[i])
        h = h + 0.5 * _swiglu(_rmsnorm(h, ffn_norm[layer, 1]), ffn_w_gate[layer, 1],
                              ffn_w_up[layer, 1], ffn_w_down[layer, 1])
    return h
```

```cpp
#include <hip/hip_runtime.h>
#include <hip/hip_cooperative_groups.h>
#include <cstdio>
#include <cstdint>
namespace cg = cooperative_groups;

namespace pg8 {
#define PG8_LAS __attribute__((address_space(3)))
typedef unsigned short bf16_t;
typedef short bf16x8 __attribute__((ext_vector_type(8)));
typedef float f32x4 __attribute__((ext_vector_type(4)));
typedef float f32x16 __attribute__((ext_vector_type(16)));
typedef unsigned u32x4 __attribute__((ext_vector_type(4)));
typedef unsigned u32x2 __attribute__((ext_vector_type(2)));
constexpr int BM = 256, BK = 64, HALF = 128, HTB = HALF * BK * 2  , STAGE_BYTES = 8 * HTB, NXCD = 8, WGM = 4;

__host__ __device__ __forceinline__ int lds_byte(int r, int c) { const int st = (r >> 4) * 2 + (c >> 5), rr = r & 15, cc = c & 31, ob = rr * 64 + cc * 2; return st * 1024 + (ob ^ (((ob >> 9) & 1) << 5)); }
__host__ __device__ __forceinline__ void stage_rc(int b, int& R, int& C) { const int st = b / 1024, sb = b % 1024, swz = sb ^ (((sb >> 9) & 1) << 5); R = (st >> 1) * 16 + swz / 64; C = (st & 1) * 32 + (swz % 64) / 2; }
__host__ __device__ __forceinline__ int perm32(int rho) { const int n = rho >> 4, i = rho & 15; return 8 * (i >> 2) + 4 * n + (i & 3); }

struct Unit { int pm, pn; };
struct Gemm { const bf16_t* A; const bf16_t* Bt; int M, N, K, lda, ldb; };

struct StaticOrder {
    int nM, nN, nwg, G, c;
    __host__ __device__ void init(int M, int N, int G_, int c_) { nM = M / BM; nN = N / BM; nwg = nM * nN; G = G_; c = c_; }
    __host__ __device__ bool next(int i, Unit& u) const {
        const long L = (long)i * G + c; if (L >= nwg) return false;
        int wgid = (int)L; { const int q = nwg / NXCD, r = nwg % NXCD, xcd = wgid % NXCD, off = wgid / NXCD; wgid = (xcd < r ? xcd * (q + 1) : r * (q + 1) + (xcd - r) * q) + off; }
        const int nig = WGM * nN, gid = wgid / nig, fm = gid * WGM, gsz = (nM - fm) < WGM ? (nM - fm) : WGM;
        u.pm = fm + ((wgid % nig) % gsz); u.pn = (wgid % nig) / gsz; return true;
    }
    __device__ __forceinline__ void a_ready(const Unit&) const {}
    __device__ __forceinline__ void done(const Unit&) const {}
    __device__ __forceinline__ int kt0(const Unit&) const { return 0; }
    __device__ __forceinline__ int ktn(const Unit&, int nt) const { return nt; }
};
struct QkvOrder : StaticOrder {
    __device__ __forceinline__ int kt0(const Unit& u) const { return u.pn < 3 ? 0 : 4; }
    __device__ __forceinline__ int ktn(const Unit& u, int) const { return u.pn < 3 ? 4 : 2; }
};

typedef float f32x2c_ __attribute__((ext_vector_type(2))); typedef __bf16 bf16x2c_ __attribute__((ext_vector_type(2)));
__device__ __forceinline__ unsigned cvt_pk_bf16(float lo, float hi) { const f32x2c_ v = {lo, hi}; const bf16x2c_ b = __builtin_convertvector(v, bf16x2c_); return __builtin_bit_cast(unsigned, b); }
constexpr float EPS = 1e-6f;
template <int N> __device__ __forceinline__ float sxor(float v) { static_assert(N > 0 && N < 32, "sxor"); return __int_as_float(__builtin_amdgcn_ds_swizzle(__float_as_int(v), 0x1f | (N << 10))); }
__device__ __forceinline__ float sum32(float v) { const auto rr = __builtin_amdgcn_permlane32_swap(__float_as_uint(v), __float_as_uint(v), false, false); return __uint_as_float(rr[0]) + __uint_as_float(rr[1]); }
__device__ __forceinline__ float max32(float v) { const auto rr = __builtin_amdgcn_permlane32_swap(__float_as_uint(v), __float_as_uint(v), false, false); return fmaxf(__uint_as_float(rr[0]), __uint_as_float(rr[1])); }
__device__ __forceinline__ float hsum4(f32x4 a) { return (a[0] + a[1]) + (a[2] + a[3]); }
__device__ __forceinline__ float dot4(f32x4 a) { return (a[0] * a[0] + a[1] * a[1]) + (a[2] * a[2] + a[3] * a[3]); }
__device__ __forceinline__ float rstd16(const float* ss, int row, float invn, int fq) {
    const f32x4 a = ((const f32x4*)(ss + (size_t)row * 16))[fq];
    float s = hsum4(a); s += sxor<16>(s); s = sum32(s);
    return __builtin_amdgcn_rsqf(s * invn + EPS);
}
__device__ __forceinline__ float rstd16_full(const float* ss, int row, float invn) {
    const f32x4* p = (const f32x4*)(ss + (size_t)row * 16);
    const f32x4 a = p[0], b = p[1], c = p[2], d = p[3];
    const float s = (hsum4(a) + hsum4(b)) + (hsum4(c) + hsum4(d));
    return __builtin_amdgcn_rsqf(s * invn + EPS);
}
__device__ __forceinline__ float gelu_tanh(float x) {
    const float t = x * (1.5957691216057308f + 0.07135481627f * x * x);
    return x * __builtin_amdgcn_rcpf(1.0f + __builtin_amdgcn_exp2f(-1.4426950408889634f * t));
}

typedef float f32x2 __attribute__((ext_vector_type(2)));
__device__ __forceinline__ void stat_issue(const float* ss, const Unit& u, int wr, int fr, int fq, f32x4 (&raw)[8]) {
#pragma unroll
    for (int ai = 0; ai < 2; ++ai)
#pragma unroll
        for (int m = 0; m < 4; ++m) raw[ai * 4 + m] = ((const f32x4*)(ss + (size_t)(u.pm * BM + ai * HALF + wr * 64 + m * 16 + fr) * 16))[fq];
}
__device__ __forceinline__ void stat_finish(const f32x4 (&raw)[8], float (&rs)[8], float invn) {
#pragma unroll
    for (int r = 0; r < 8; ++r) { float s = hsum4(raw[r]); s += sxor<16>(s); s = sum32(s); rs[r] = __builtin_amdgcn_rsqf(s * invn + EPS); }
}
__device__ __forceinline__ f32x2 sigmoid_pk(f32x2 t) {
    const f32x2 a = t * (-1.4426950408889634f); f32x2 e; e.x = __builtin_amdgcn_exp2f(a.x); e.y = __builtin_amdgcn_exp2f(a.y);
    const f32x2 d = e + 1.0f; f32x2 r; r.x = __builtin_amdgcn_rcpf(d.x); r.y = __builtin_amdgcn_rcpf(d.y); return r;
}
__device__ __forceinline__ f32x2 gelu_tanh_pk(f32x2 x) { const f32x2 t = x * (x * x * 0.07135481627f + 1.5957691216057308f); return x * sigmoid_pk(t); }
struct EpiSwiGLU {
    static constexpr bool PERM = true, AFTER_DRAIN = false, PRE = true;
    bf16_t* hid; const float* ss; int ldh;
    __device__ __forceinline__ void pre_issue(const Unit& u, int wr, int fr, int fq, f32x4 (&raw)[8]) const { stat_issue(ss, u, wr, fr, fq, raw); }
    __device__ __forceinline__ void pre_finish(const f32x4 (&raw)[8], float (&rs)[8]) const { stat_finish(raw, rs, 1.0f / 1024.0f); }
    __device__ __forceinline__ void operator()(const f32x4 (&acc)[2][2][4][2], const Unit& u, int wr, int wc, int fr, int fq, const float (&rsv)[8]) const {
#pragma unroll
        for (int ai = 0; ai < 2; ++ai)
#pragma unroll
            for (int m = 0; m < 4; ++m) {
                const int row = u.pm * BM + ai * HALF + wr * 64 + m * 16 + fr;
                const float rs = rsv[ai * 4 + m];
                u32x4 w;
#pragma unroll
                for (int n = 0; n < 2; ++n) {
                    const f32x4 g = acc[ai][0][m][n] * rs, up = acc[ai][1][m][n] * rs;
                    const f32x2 g0 = {g[0], g[1]}, g1 = {g[2], g[3]}, u0 = {up[0], up[1]}, u1 = {up[2], up[3]};
                    const f32x2 h0 = (g0 * u0) * sigmoid_pk(g0), h1 = (g1 * u1) * sigmoid_pk(g1);
                    w[2 * n] = cvt_pk_bf16(h0.x, h0.y); w[2 * n + 1] = cvt_pk_bf16(h1.x, h1.y);
                }
                *(u32x4*)(hid + (size_t)row * ldh + u.pn * 128 + wc * 32 + 8 * fq) = w;
            }
    }
};
struct EpiResid {
    static constexpr bool PERM = true, AFTER_DRAIN = false, PRE = false;
    const float* xf; float* outf; bf16_t* hb; float* ss; float alpha;
    __device__ __forceinline__ void pre_issue(const Unit&, int, int, int, f32x4 (&)[8]) const {}
    __device__ __forceinline__ void pre_finish(const f32x4 (&)[8], float (&)[8]) const {}
    __device__ __forceinline__ void operator()(const f32x4 (&acc)[2][2][4][2], const Unit& u, int wr, int wc, int fr, int fq, const float (&)[8]) const {
        const size_t off0 = (size_t)(u.pm * BM + wr * 64 + fr) * 1024 + u.pn * BM + wc * 32 + 8 * fq;
        u32x4 raw[8][2];
        if (!xf) {
#pragma unroll
            for (int r = 0; r < 8; ++r)
#pragma unroll
                for (int bj = 0; bj < 2; ++bj) raw[r][bj] = *(const u32x4*)(hb + off0 + (size_t)(r >> 2) * (HALF * 1024) + (size_t)(r & 3) * (16 * 1024) + bj * HALF);
        }
#pragma unroll
        for (int ai = 0; ai < 2; ++ai)
#pragma unroll
            for (int m = 0; m < 4; ++m) {
                const int row = u.pm * BM + ai * HALF + wr * 64 + m * 16 + fr; float sq = 0.f;
#pragma unroll
                for (int bj = 0; bj < 2; ++bj) {
                    const size_t off = off0 + (size_t)ai * (HALF * 1024) + (size_t)m * (16 * 1024) + bj * HALF;
                    f32x4 b0, b1;
                    if (xf) { b0 = *(const f32x4*)(xf + off); b1 = *(const f32x4*)(xf + off + 4); }
                    else { const u32x4 w = raw[ai * 4 + m][bj];
                        b0[0] = __uint_as_float(w.x << 16); b0[1] = __uint_as_float(w.x & 0xffff0000u); b0[2] = __uint_as_float(w.y << 16); b0[3] = __uint_as_float(w.y & 0xffff0000u);
                        b1[0] = __uint_as_float(w.z << 16); b1[1] = __uint_as_float(w.z & 0xffff0000u); b1[2] = __uint_as_float(w.w << 16); b1[3] = __uint_as_float(w.w & 0xffff0000u); }
                    const f32x4 o0 = b0 + acc[ai][bj][m][0] * alpha, o1 = b1 + acc[ai][bj][m][1] * alpha;
                    if (outf) { *(f32x4*)(outf + off) = o0; *(f32x4*)(outf + off + 4) = o1; }
                    sq += dot4(o0) + dot4(o1);
                    u32x4 w; w.x = cvt_pk_bf16(o0[0], o0[1]); w.y = cvt_pk_bf16(o0[2], o0[3]); w.z = cvt_pk_bf16(o1[0], o1[1]); w.w = cvt_pk_bf16(o1[2], o1[3]);
                    *(u32x4*)(hb + off) = w;
                }
                sq += sxor<16>(sq); sq = sum32(sq);
                if (fq == 0) ss[(size_t)row * 16 + u.pn * 4 + wc] = sq;
            }
    }
};
template <int MODE> struct EpiRowBf16 {
    static constexpr bool PERM = true, AFTER_DRAIN = false, PRE = true;
    bf16_t* O; int ldc; const float* ss; float* ssq; float* sskv;
    __device__ __forceinline__ void pre_issue(const Unit& u, int wr, int fr, int fq, f32x4 (&raw)[8]) const { stat_issue(ss, u, wr, fr, fq, raw); }
    __device__ __forceinline__ void pre_finish(const f32x4 (&raw)[8], float (&rs)[8]) const { stat_finish(raw, rs, 1.0f / 1024.0f); }
    __device__ __forceinline__ void operator()(const f32x4 (&acc)[2][2][4][2], const Unit& u, int wr, int wc, int fr, int fq, const float (&rsv)[8]) const {
#pragma unroll
        for (int ai = 0; ai < 2; ++ai)
#pragma unroll
            for (int m = 0; m < 4; ++m) {
                const int row = u.pm * BM + ai * HALF + wr * 64 + m * 16 + fr;
                const float rs = rsv[ai * 4 + m]; float sq = 0.f;
#pragma unroll
                for (int bj = 0; bj < 2; ++bj) {
                    f32x4 v0 = acc[ai][bj][m][0] * rs, v1 = acc[ai][bj][m][1] * rs;
                    if (MODE == 1) {
                        const f32x2 a = gelu_tanh_pk((f32x2){v0[0], v0[1]}), b = gelu_tanh_pk((f32x2){v0[2], v0[3]}), c = gelu_tanh_pk((f32x2){v1[0], v1[1]}), d = gelu_tanh_pk((f32x2){v1[2], v1[3]});
                        v0 = (f32x4){a.x, a.y, b.x, b.y}; v1 = (f32x4){c.x, c.y, d.x, d.y};
                    }
                    if (MODE == 2) { if (u.pn == 0 || bj == 0) sq += dot4(v0) + dot4(v1); }
                    u32x4 w; w.x = cvt_pk_bf16(v0[0], v0[1]); w.y = cvt_pk_bf16(v0[2], v0[3]); w.z = cvt_pk_bf16(v1[0], v1[1]); w.w = cvt_pk_bf16(v1[2], v1[3]);
                    *(u32x4*)(O + (size_t)row * ldc + u.pn * BM + bj * HALF + wc * 32 + 8 * fq) = w;
                }
                if (MODE == 2) {
                    sq += sxor<16>(sq); sq = sum32(sq);
                    if (fq == 0) { if (u.pn == 0) ssq[(size_t)row * 4 + wc] = sq; else if (u.pn == 1) sskv[(size_t)row * 4 + wc] = sq; }
                }
            }
    }
};
struct EpiQKV {
    static constexpr bool PERM = true, AFTER_DRAIN = false, PRE = true;
    bf16_t* O; int ldc; const float* ssq; const float* sskv;
    __device__ __forceinline__ void pre_issue(const Unit& u, int wr, int fr, int fq, f32x4 (&raw)[8]) const {
        const bool isq = u.pn < 3; const float* ssp = isq ? ssq : sskv; const float invn = isq ? 1.0f / 256.0f : 1.0f / 128.0f;
#pragma unroll
        for (int r = 0; r < 8; ++r) raw[r][0] = ssp[(size_t)(u.pm * BM + (r >> 2) * HALF + wr * 64 + (r & 3) * 16 + fr) * 4 + fq];
        raw[0][1] = invn;
    }
    __device__ __forceinline__ void pre_finish(const f32x4 (&raw)[8], float (&rs)[8]) const {
#pragma unroll
        for (int r = 0; r < 8; ++r) { float sp = raw[r][0]; sp += sxor<16>(sp); sp = sum32(sp); rs[r] = __builtin_amdgcn_rsqf(sp * raw[0][1] + EPS); }
    }
    __device__ __forceinline__ void operator()(const f32x4 (&acc)[2][2][4][2], const Unit& u, int wr, int wc, int fr, int fq, const float (&rsv)[8]) const {
#pragma unroll
        for (int ai = 0; ai < 2; ++ai)
#pragma unroll
            for (int m = 0; m < 4; ++m) {
                const int row = u.pm * BM + ai * HALF + wr * 64 + m * 16 + fr;
                const float rs = rsv[ai * 4 + m];
#pragma unroll
                for (int bj = 0; bj < 2; ++bj) {
                    const f32x4 v0 = acc[ai][bj][m][0] * rs, v1 = acc[ai][bj][m][1] * rs;
                    u32x4 w; w.x = cvt_pk_bf16(v0[0], v0[1]); w.y = cvt_pk_bf16(v0[2], v0[3]); w.z = cvt_pk_bf16(v1[0], v1[1]); w.w = cvt_pk_bf16(v1[2], v1[3]);
                    *(u32x4*)(O + (size_t)row * ldc + u.pn * BM + bj * HALF + wc * 32 + 8 * fq) = w;
                }
            }
    }
};
struct EpiVt {
    static constexpr bool PERM = true, AFTER_DRAIN = false, PRE = false;
    bf16_t* vT; const float* ss; float* ssv;
    __device__ __forceinline__ void pre_issue(const Unit&, int, int, int, f32x4 (&)[8]) const {}
    __device__ __forceinline__ void pre_finish(const f32x4 (&)[8], float (&)[8]) const {}
    __device__ __forceinline__ void operator()(const f32x4 (&acc)[2][2][4][2], const Unit& u, int wr, int wc, int fr, int fq, const float (&)[8]) const {
#pragma unroll
        for (int bj = 0; bj < 2; ++bj) {
            const int tok0 = u.pn * BM + bj * HALF + wc * 32 + 8 * fq;
            float rs[8], sq[8];
            {
                const f32x4* pp = (const f32x4*)(ss + (size_t)(tok0 + (fr >> 1)) * 16 + (fr & 1) * 8);
                float sp = hsum4(pp[0]) + hsum4(pp[1]); sp += sxor<1>(sp);
                const float rv = __builtin_amdgcn_rsqf(sp * (1.0f / 1024.0f) + EPS);
                const int lbase = (fq << 4);
#pragma unroll
                for (int t = 0; t < 8; ++t) { rs[t] = __shfl(rv, lbase + 2 * t); sq[t] = 0.f; }
            }
            const size_t cbase = (size_t)(tok0 >> 7) * (1024 * 128) + (tok0 & 127);
#pragma unroll
            for (int ai = 0; ai < 2; ++ai)
#pragma unroll
                for (int m = 0; m < 4; ++m) {
                    const int c = u.pm * BM + ai * HALF + wr * 64 + m * 16 + fr;
                    float v[8];
#pragma unroll
                    for (int t = 0; t < 8; t += 2) { const f32x2 y = gelu_tanh_pk((f32x2){acc[ai][bj][m][t >> 2][t & 3] * rs[t], acc[ai][bj][m][t >> 2][(t & 3) + 1] * rs[t + 1]}); v[t] = y.x; v[t + 1] = y.y; sq[t] += y.x * y.x; sq[t + 1] += y.y * y.y; }
                    u32x4 w; w.x = cvt_pk_bf16(v[0], v[1]); w.y = cvt_pk_bf16(v[2], v[3]); w.z = cvt_pk_bf16(v[4], v[5]); w.w = cvt_pk_bf16(v[6], v[7]);
                    *(u32x4*)(vT + cbase + (size_t)c * 128) = w;
                }
#pragma unroll
            for (int t = 0; t < 8; ++t) {
                float s = sq[t]; s += sxor<1>(s); s += sxor<2>(s); s += sxor<4>(s); s += sxor<8>(s);
                if (fr == 0) ssv[(size_t)(tok0 + t) * 8 + u.pm * 2 + wr] = s;
            }
        }
    }
};

template <class Epi, class Sched, bool ALIGN_EPI = false, bool SP2 = false>
__device__ __forceinline__ void gemm_phase(PG8_LAS unsigned char* lds, const Gemm g, const Sched& S, const Epi& E) {
    int tid_ = threadIdx.x; asm volatile("" : "+v"(tid_));
    const int tid = tid_, wid = __builtin_amdgcn_readfirstlane(tid >> 6), lane = tid & 63, wr = wid >> 2, wc = wid & 3, fr = lane & 15, fq = lane >> 4;
    int K_ = g.K; asm volatile("" : "+s"(K_));
    const int K = K_, nt = K / BK;
    unsigned voffA[2], voffB[2];
#pragma unroll
    for (int i = 0; i < 2; ++i) { int R, C; stage_rc(tid * 16 + i * 8192, R, C); const int Rb = Epi::PERM ? ((R & ~31) + perm32(R & 31)) : R;
        voffA[i] = (unsigned)(R * g.lda + C) * 2u; voffB[i] = (unsigned)(Rb * g.ldb + C) * 2u; }
    const size_t kstep = (size_t)(BK * 2);
    const size_t hstepA = (size_t)HALF * g.lda * 2, hstepB = (size_t)HALF * g.ldb * 2;
    const size_t tstepA = 2 * hstepA, tstepB = 2 * hstepB;
    const unsigned ldsw = (unsigned)wid * 1024u;
    const int aoff = lds_byte(wr * 64 + fr, fq * 8), boff = lds_byte(wc * 32 + fr, fq * 8);
#define PG8_SA(b, h) (((b) * 2 + (h)) * HTB)
#define PG8_SB(b, h) ((4 + (b) * 2 + (h)) * HTB)
#define PG8_STAGE(bufoff, gbase, voff) do { _Pragma("unroll") for (int _i = 0; _i < 2; ++_i) \
        __builtin_amdgcn_global_load_lds((const unsigned*)((const char*)(gbase) + (voff)[_i]), (PG8_LAS unsigned*)(lds + (bufoff) + ldsw + _i * 8192), 16, 0, 0); } while (0)
#define PG8_LDA(dst, b, h) do { _Pragma("unroll") for (int m = 0; m < 4; ++m) _Pragma("unroll") for (int k = 0; k < 2; ++k) dst[m][k] = *(const PG8_LAS bf16x8*)(lds + PG8_SA(b, h) + aoff + m * 2048 + k * 1024); } while (0)
#define PG8_LDB(dst, b, h) do { _Pragma("unroll") for (int n = 0; n < 2; ++n) _Pragma("unroll") for (int k = 0; k < 2; ++k) dst[n][k] = *(const PG8_LAS bf16x8*)(lds + PG8_SB(b, h) + boff + n * 2048 + k * 1024); } while (0)
#define PG8_MMA(ai, bj, At, Bt) do { __builtin_amdgcn_s_setprio(1); _Pragma("unroll") for (int m = 0; m < 4; ++m) _Pragma("unroll") for (int n = 0; n < 2; ++n) _Pragma("unroll") for (int k = 0; k < 2; ++k) \
        acc[ai][bj][m][n] = __builtin_amdgcn_mfma_f32_16x16x32_bf16(Bt[n][k], At[m][k], acc[ai][bj][m][n], 0, 0, 0); __builtin_amdgcn_s_setprio(0); } while (0)
#define PG8_WAIT_V(n) asm volatile("s_waitcnt vmcnt(" #n ")" ::: "memory")
#define PG8_WAIT_L(n) asm volatile("s_waitcnt lgkmcnt(" #n ")" ::: "memory")
#define PG8_BAR __builtin_amdgcn_s_barrier()
#define PG8_SCHED __builtin_amdgcn_sched_barrier(0)
    Unit cur, nxt; int ui = 0;
    if (!S.next(0, cur)) return;
    float rs_[8];
#pragma unroll
    for (int r = 0; r < 8; ++r) rs_[r] = 0.f;
    if constexpr (Epi::PRE) { f32x4 raw0_[8]; E.pre_issue(cur, wr, fr, fq, raw0_); E.pre_finish(raw0_, rs_); }
    f32x4 acc[2][2][4][2];
#pragma unroll
    for (int a = 0; a < 2; ++a)
#pragma unroll
        for (int b = 0; b < 2; ++b)
#pragma unroll
            for (int m = 0; m < 4; ++m)
#pragma unroll
                for (int n = 0; n < 2; ++n) acc[a][b][m][n] = (f32x4){0.f, 0.f, 0.f, 0.f};
    bf16x8 At[4][2], B0[2][2], B1[2][2];
    const char* cA = (const char*)g.A + (size_t)cur.pm * tstepA + (size_t)S.kt0(cur) * (BK * 2); const char* cB = (const char*)g.Bt + (size_t)cur.pn * tstepB + (size_t)S.kt0(cur) * (BK * 2);
    int ntc = S.ktn(cur, nt);
    S.a_ready(cur);
    if constexpr (SP2) {
        PG8_STAGE(PG8_SB(0, 0), cB, voffB); PG8_STAGE(PG8_SB(0, 1), cB + hstepB, voffB); PG8_STAGE(PG8_SA(0, 0), cA, voffA); PG8_STAGE(PG8_SA(0, 1), cA + hstepA, voffA);
        if (wr == 1) PG8_BAR;
        PG8_WAIT_V(2); PG8_BAR;
        PG8_STAGE(PG8_SB(1, 0), cB + kstep, voffB); PG8_STAGE(PG8_SA(1, 0), cA + kstep, voffA); PG8_STAGE(PG8_SB(1, 1), cB + hstepB + kstep, voffB);
        PG8_WAIT_V(6); PG8_BAR;
    } else {
        PG8_STAGE(PG8_SB(0, 0), cB, voffB); PG8_STAGE(PG8_SA(0, 0), cA, voffA); PG8_STAGE(PG8_SB(0, 1), cB + hstepB, voffB); PG8_STAGE(PG8_SA(0, 1), cA + hstepA, voffA);
        if (wr == 1) PG8_BAR;
        PG8_WAIT_V(4); PG8_BAR;
        PG8_STAGE(PG8_SB(1, 0), cB + kstep, voffB); PG8_STAGE(PG8_SA(1, 0), cA + kstep, voffA); PG8_STAGE(PG8_SB(1, 1), cB + hstepB + kstep, voffB);
        PG8_WAIT_V(6); PG8_BAR;
    }
    for (;;) {
        const bool has_next = S.next(ui + 1, nxt);
        const char* nA = has_next ? (const char*)g.A + (size_t)nxt.pm * tstepA + (size_t)S.kt0(nxt) * (BK * 2) : cA; const char* nB = has_next ? (const char*)g.Bt + (size_t)nxt.pn * tstepB + (size_t)S.kt0(nxt) * (BK * 2) : cB;
        for (int t = 0; t < ntc; t += 2) {
            const bool last = (t == ntc - 2);
            const char* a1 = cA + (size_t)(t + 1) * kstep;
            const char* a2 = last ? nA : cA + (size_t)(t + 2) * kstep; const char* b2 = last ? nB : cB + (size_t)(t + 2) * kstep;
            const char* a3 = a2 + kstep; const char* b3 = b2 + kstep;
            if (last && has_next) S.a_ready(nxt);
            if constexpr (SP2) {
            PG8_LDB(B0, 0, 0); PG8_LDB(B1, 0, 1); PG8_SCHED; PG8_LDA(At, 0, 0); PG8_STAGE(PG8_SA(1, 1), a1 + hstepA, voffA);
            PG8_WAIT_V(8); PG8_WAIT_L(0); PG8_BAR; PG8_MMA(0, 0, At, B0); PG8_MMA(0, 1, At, B1); PG8_BAR; PG8_SCHED;
            PG8_LDA(At, 0, 1); PG8_STAGE(PG8_SB(0, 0), b2, voffB); PG8_STAGE(PG8_SB(0, 1), b2 + hstepB, voffB); PG8_STAGE(PG8_SA(0, 0), a2, voffA);
            PG8_WAIT_V(8); PG8_WAIT_L(0); PG8_BAR; PG8_MMA(1, 0, At, B0); PG8_MMA(1, 1, At, B1); PG8_BAR; PG8_SCHED;
            PG8_LDB(B0, 1, 0); PG8_LDB(B1, 1, 1); PG8_SCHED; PG8_LDA(At, 1, 0); PG8_STAGE(PG8_SA(0, 1), a2 + hstepA, voffA);
            PG8_WAIT_V(8); PG8_WAIT_L(0); PG8_BAR; PG8_MMA(0, 0, At, B0); PG8_MMA(0, 1, At, B1); PG8_BAR; PG8_SCHED;
            PG8_LDA(At, 1, 1); PG8_STAGE(PG8_SB(1, 0), b3, voffB); PG8_STAGE(PG8_SB(1, 1), b3 + hstepB, voffB); PG8_STAGE(PG8_SA(1, 0), a3, voffA);
            PG8_WAIT_V(8); PG8_WAIT_L(0); PG8_BAR; PG8_MMA(1, 0, At, B0); PG8_MMA(1, 1, At, B1); PG8_BAR; PG8_SCHED;
            } else {
            PG8_LDB(B0, 0, 0); PG8_SCHED; PG8_LDA(At, 0, 0); PG8_STAGE(PG8_SA(1, 1), a1 + hstepA, voffA);
            PG8_WAIT_L(8); PG8_BAR; PG8_WAIT_L(0); PG8_MMA(0, 0, At, B0); PG8_BAR; PG8_SCHED;
            PG8_LDB(B1, 0, 1); PG8_STAGE(PG8_SB(0, 0), b2, voffB);
            PG8_BAR; PG8_WAIT_L(0); PG8_MMA(0, 1, At, B1); PG8_BAR;
            PG8_LDA(At, 0, 1); PG8_STAGE(PG8_SA(0, 0), a2, voffA);
            PG8_BAR; PG8_WAIT_L(0); PG8_MMA(1, 0, At, B0); PG8_BAR; PG8_SCHED;
            PG8_STAGE(PG8_SB(0, 1), b2 + hstepB, voffB);
            PG8_WAIT_V(6); PG8_BAR; PG8_MMA(1, 1, At, B1); PG8_BAR;
            PG8_LDB(B0, 1, 0); PG8_SCHED; PG8_LDA(At, 1, 0); PG8_STAGE(PG8_SA(0, 1), a2 + hstepA, voffA);
            PG8_WAIT_L(8); PG8_BAR; PG8_WAIT_L(0); PG8_MMA(0, 0, At, B0); PG8_BAR; PG8_SCHED;
            PG8_LDB(B1, 1, 1); PG8_STAGE(PG8_SB(1, 0), b3, voffB);
            PG8_BAR; PG8_WAIT_L(0); PG8_MMA(0, 1, At, B1); PG8_BAR;
            PG8_LDA(At, 1, 1); PG8_STAGE(PG8_SA(1, 0), a3, voffA);
            PG8_BAR; PG8_WAIT_L(0); PG8_MMA(1, 0, At, B0); PG8_BAR; PG8_SCHED;
            PG8_STAGE(PG8_SB(1, 1), b3 + hstepB, voffB);
            PG8_WAIT_V(6); PG8_BAR; PG8_MMA(1, 1, At, B1); PG8_BAR;
            }
        }
        if constexpr (ALIGN_EPI) { if (wr == 0) PG8_BAR; }
        if constexpr (!Epi::AFTER_DRAIN) { int fr_e = fr, fq_e = fq; asm volatile("" : "+v"(fr_e), "+v"(fq_e)); f32x4 raw_[8]; const Unit pu_ = has_next ? nxt : cur; if constexpr (Epi::PRE) E.pre_issue(pu_, wr, fr_e, fq_e, raw_); E(acc, cur, wr, wc, fr_e, fq_e, rs_); if constexpr (Epi::PRE) E.pre_finish(raw_, rs_); S.done(cur); }
        if (!has_next) break;
#pragma unroll
        for (int a = 0; a < 2; ++a)
#pragma unroll
            for (int b = 0; b < 2; ++b)
#pragma unroll
                for (int m = 0; m < 4; ++m)
#pragma unroll
                    for (int n = 0; n < 2; ++n) acc[a][b][m][n] = (f32x4){0.f, 0.f, 0.f, 0.f};
        cur = nxt; cA = nA; cB = nB; ++ui; ntc = S.ktn(cur, nt);
        if constexpr (ALIGN_EPI) { if (wr == 1) PG8_BAR; }
    }
    PG8_WAIT_V(0);
    if constexpr (!ALIGN_EPI) { if (wr == 0) PG8_BAR; }
    PG8_BAR;
    if constexpr (Epi::AFTER_DRAIN) { E.fused(acc, cur, wr, wc, fr, fq, lds, wid, lane); S.done(cur); }
#undef PG8_SA
#undef PG8_SB
#undef PG8_STAGE
#undef PG8_LDA
#undef PG8_LDB
#undef PG8_MMA
#undef PG8_WAIT_V
#undef PG8_WAIT_L
#undef PG8_BAR
#undef PG8_SCHED
}
}

using pg8::bf16_t; using pg8::bf16x8; using pg8::f32x4; using pg8::f32x16; using pg8::u32x4; using pg8::u32x2; using pg8::cvt_pk_bf16; using pg8::EPS;
#define LAS __attribute__((address_space(3)))
constexpr int NB = 16, SEQ = 4096, D = 1024, M = NB * SEQ, FF = 2816, NH = 8, NTHR = 512;
constexpr size_t MiB = 1u << 20;
constexpr size_t WS_SSH = 0, WS_SSQ = 4 * MiB, WS_SSKV = 5 * MiB, WS_SSV = 6 * MiB, WS_CS = 8 * MiB, WS_W = 16 * MiB;
constexpr size_t FFN_W_BYTES = 16 * MiB + 512 * 1024;
constexpr size_t WS_EVEN = WS_W + 8 * FFN_W_BYTES;
constexpr size_t WS_ODD = WS_EVEN + 12 * MiB;
constexpr size_t WS_HB = WS_ODD + 12 * MiB;
constexpr size_t WS_A = WS_HB + 128 * MiB;
constexpr size_t WS_B = WS_A + 352 * MiB;
constexpr size_t WS_MIX = WS_B + 224 * MiB;
constexpr size_t WS_END = WS_MIX + 128 * MiB;
constexpr int LDS_BYTES = 147456, LDS_TAB = 131072, LDS_MISC = 135168;
constexpr size_t WS_CTL = WS_EVEN + 3 * MiB + 512 * 1024, CTL_BYTES = 16384;
constexpr float C2Q = 0.10206207261596577f * 1.4426950408889634f;

struct Args { const float* in[22]; float* out; unsigned char* ws; };

__device__ __forceinline__ float bf2f(unsigned short b) { return __uint_as_float((unsigned)b << 16); }
__device__ __forceinline__ void unpack8(u32x4 w, float* v) {
#pragma unroll
    for (int i = 0; i < 4; ++i) { v[2 * i] = __uint_as_float(w[i] << 16); v[2 * i + 1] = __uint_as_float(w[i] & 0xffff0000u); }
}
__device__ __forceinline__ u32x4 pack8(const float* v) { u32x4 w; w.x = cvt_pk_bf16(v[0], v[1]); w.y = cvt_pk_bf16(v[2], v[3]); w.z = cvt_pk_bf16(v[4], v[5]); w.w = cvt_pk_bf16(v[6], v[7]); return w; }
#define LDS_WAIT() asm volatile("s_waitcnt lgkmcnt(0)" ::: "memory")
__device__ __forceinline__ int otid() { int t = threadIdx.x; asm volatile("" : "+v"(t)); return t; }
__device__ __forceinline__ unsigned char* oq(unsigned char* p) { asm volatile("" : "+s"(p)); return p; }
template <int KSLOT> __device__ __forceinline__ unsigned long long karg_u64() {
    const unsigned long long base = (unsigned long long)__builtin_amdgcn_kernarg_segment_ptr(); unsigned long long v;
    asm volatile("s_load_dwordx2 %0, %1, %2\n\ts_waitcnt lgkmcnt(0)" : "=s"(v) : "s"(base), "n"(KSLOT * 8) : "memory");
    return v;
}
#define GASQ __attribute__((address_space(1)))
#define KIN(k) ((const float*)(const GASQ float*)karg_u64<(k)>())
#define KOUT ((float*)(GASQ float*)karg_u64<22>())
#define KWS ((unsigned char*)(GASQ unsigned char*)karg_u64<23>())

__device__ __forceinline__ void tr_item(const float* W, int N, const float* gain, bf16_t* dst, int ldd, int koff, int mode, int row_off, int kb, int nb, LAS float* scr, int lane) {
    const int k0 = 64 * kb, n0 = 32 * nb;
#pragma unroll
    for (int i = 0; i < 8; ++i) { const int kk = 8 * i + (lane >> 3), c4 = 4 * (lane & 7); f32x4 v = *(const f32x4*)(W + (size_t)(k0 + kk) * N + n0 + c4); if (gain) v = v * gain[k0 + kk];
        scr[kk * 33 + c4] = v[0]; scr[kk * 33 + c4 + 1] = v[1]; scr[kk * 33 + c4 + 2] = v[2]; scr[kk * 33 + c4 + 3] = v[3]; }
    LDS_WAIT();
    const int c = lane & 7;
#pragma unroll
    for (int j = 0; j < 4; ++j) {
        const int n = (lane >> 3) + 8 * j, nn = n0 + n;
        const int row = (mode == 0) ? (row_off + nn) : (256 * (nn >> 7) + (nn & 127) + (mode == 2 ? 128 : 0));
        const LAS float* s = scr + (8 * c) * 33 + n;
        u32x4 o; o.x = cvt_pk_bf16(s[0 * 33], s[1 * 33]); o.y = cvt_pk_bf16(s[2 * 33], s[3 * 33]); o.z = cvt_pk_bf16(s[4 * 33], s[5 * 33]); o.w = cvt_pk_bf16(s[6 * 33], s[7 * 33]);
        *(u32x4*)(dst + (size_t)row * ldd + koff + k0 + 8 * c) = o;
    }
    LDS_WAIT();
}
constexpr int IT_MAT = 1408, IT_FFN = 3 * IT_MAT, IT_FFN_ALL = 8 * IT_FFN, IT_EVEN = 880, IT_ODD = 1536, IT_TOTAL = IT_FFN_ALL + 2 * IT_EVEN + 2 * IT_ODD;

__device__ __forceinline__ void prologue(LAS unsigned char* lds, int G) {
    const int tid = otid(), lane = tid & 63, wave = __builtin_amdgcn_readfirstlane(tid >> 6);
    unsigned char* ws = KWS;
    const int gw = blockIdx.x * 8 + wave, NGW = G * 8;
    const int gt = blockIdx.x * NTHR + tid, NGT = G * NTHR;
    LAS float* scr = (LAS float*)(lds + wave * 16384);
    for (int it0 = gw; it0 < IT_TOTAL; it0 += NGW) {
        int it = it0;
        if (it < IT_FFN_ALL) {
            const int f = it / IT_FFN, r = it % IT_FFN, mat = r / IT_MAT, q = r % IT_MAT;
            bf16_t* wgu = (bf16_t*)(ws + WS_W + (size_t)f * FFN_W_BYTES); bf16_t* wd = wgu + (size_t)5632 * 1024;
            if (mat == 0) tr_item(KIN(3) + (size_t)f * 1024 * FF, FF, KIN(2) + f * 1024, wgu, 1024, 0, 1, 0, q / 88, q % 88, scr, lane);
            else if (mat == 1) tr_item(KIN(4) + (size_t)f * 1024 * FF, FF, KIN(2) + f * 1024, wgu, 1024, 0, 2, 0, q / 88, q % 88, scr, lane);
            else tr_item(KIN(5) + (size_t)f * FF * 1024, 1024, nullptr, wd, FF, 0, 0, 0, q / 32, q % 32, scr, lane);
            continue;
        }
        it -= IT_FFN_ALL;
        if (it < 2 * IT_EVEN) {
            const int e = it / IT_EVEN; int r = it % IT_EVEN;
            bf16_t* win = (bf16_t*)(ws + WS_EVEN + (size_t)e * 6 * MiB); bf16_t* wqkv = win + 1024 * 1024; bf16_t* wout = (bf16_t*)(ws + WS_EVEN + (size_t)e * 6 * MiB + 4 * MiB);
            if (r < 464) { tr_item(KIN(7) + (size_t)e * 1024 * 928, 928, KIN(6) + (2 * e) * 1024, win, 1024, 0, 0, 0, r / 29, r % 29, scr, lane); continue; }
            r -= 464;
            if (r < 96) { tr_item(KIN(10) + (size_t)e * 256 * 768, 768, KIN(8) + e * 256, wqkv, 384, 0, 0, 0, r / 24, r % 24, scr, lane); continue; }
            r -= 96;
            if (r < 64) { tr_item(KIN(11) + (size_t)e * 128 * 1024, 1024, KIN(9) + e * 128, wqkv, 384, 256, 0, 768, r / 32, r % 32, scr, lane); continue; }
            r -= 64;
            tr_item(KIN(16) + (size_t)e * 1024 * 1024, 1024, nullptr, wout, 1024, 0, 0, 0, r / 32, r % 32, scr, lane);
            continue;
        }
        it -= 2 * IT_EVEN;
        {
            const int o = it / IT_ODD; int r = it % IT_ODD;
            bf16_t* wu = (bf16_t*)(ws + WS_ODD + (size_t)o * 6 * MiB); bf16_t* wv = wu + 1024 * 1024; bf16_t* wout = wv + 1024 * 1024;
            if (r < 1024) { const int kb = r / 64, nb = r % 64; tr_item(KIN(17) + (size_t)o * 1024 * 2048, 2048, KIN(6) + (2 * o + 1) * 1024, nb < 32 ? wu : wv, 1024, 0, 0, nb < 32 ? 0 : -1024, kb, nb, scr, lane); continue; }
            r -= 1024;
            tr_item(KIN(21) + (size_t)o * 1024 * 1024, 1024, nullptr, wout, 1024, 0, 0, 0, r / 32, r % 32, scr, lane);
        }
    }
    for (int i0 = gt; i0 < 2 * 57344; i0 += NGT) {
        const int e = i0 / 57344; int i = i0 % 57344;
        bf16_t* win = (bf16_t*)(ws + WS_EVEN + (size_t)e * 6 * MiB); bf16_t* wqkv = win + 1024 * 1024;
        const u32x4 z = {0u, 0u, 0u, 0u};
        if (i < 12288) { *(u32x4*)(wqkv + (size_t)(i / 16) * 384 + 256 + 8 * (i % 16)) = z; continue; }
        i -= 12288;
        if (i < 32768) { *(u32x4*)(wqkv + (size_t)(768 + i / 32) * 384 + 8 * (i % 32)) = z; continue; }
        i -= 32768;
        *(u32x4*)(win + (size_t)(928 + i / 128) * 1024 + 8 * (i % 128)) = z;
    }
    for (int i0 = gw; i0 < 2 * 2048; i0 += NGW) {
        const int e = i0 / 2048, r = i0 % 2048, kq = r / 16, nblk = r % 16, kp = 4 * kq, g = kp >> 7, c = kp & 127, n = nblk * 64 + lane;
        const float* pw = KIN(14) + ((size_t)(e * 4 + g) * 128 + c) * 128;
        const float* sc = KIN(15) + e * 512 + g * 128;
        const float* wo = KIN(16) + (size_t)e * 1024 * 1024 + (size_t)(512 + g * 128) * 1024 + n;
        float acc[4] = {0.f, 0.f, 0.f, 0.f};
#pragma unroll 1
        for (int d0 = 0; d0 < 128; d0 += 32) {
            float wv[32];
#pragma unroll
            for (int d = 0; d < 32; ++d) wv[d] = wo[(size_t)(d0 + d) * 1024];
#pragma unroll
            for (int d = 0; d < 32; ++d) { const float w = wv[d] * sc[d0 + d];
#pragma unroll
                for (int k = 0; k < 4; ++k) acc[k] += pw[k * 128 + d0 + d] * w; }
        }
        bf16_t* wout = (bf16_t*)(ws + WS_EVEN + (size_t)e * 6 * MiB + 4 * MiB);
        u32x2 w; w.x = cvt_pk_bf16(acc[0], acc[1]); w.y = cvt_pk_bf16(acc[2], acc[3]);
        *(u32x2*)(wout + (size_t)n * 1024 + 512 + kp) = w;
    }
    {
        const int* pos = (const int*)KIN(1); float* cs = (float*)(ws + WS_CS);
        for (int i0 = gt; i0 < M * 16; i0 += NGT) {
            const int tok = i0 >> 4, i = i0 & 15;
            const float inv = (float)exp2(-(double)i * (13.287712379549449 / 16.0));
            const float ang = (float)pos[tok] * inv;
            const double rev = (double)ang * 0.15915494309189535; const float fr = (float)(rev - rint(rev));
            cs[(size_t)tok * 32 + i] = __builtin_amdgcn_cosf(fr); cs[(size_t)tok * 32 + 16 + i] = __builtin_amdgcn_sinf(fr);
        }
    }
    {
        bf16_t* hb = (bf16_t*)(ws + WS_HB); float* ssh = (float*)(ws + WS_SSH);
        const float* x0 = KIN(0);
        for (int m0 = gw; m0 < M; m0 += 4 * NGW) {
            f32x4 v[4][4]; float sq[4];
#pragma unroll
            for (int r = 0; r < 4; ++r) { const int m = m0 + r * NGW; const f32x4* xr = (const f32x4*)(x0 + (size_t)(m < M ? m : m0) * D) + lane;
#pragma unroll
                for (int j = 0; j < 4; ++j) v[r][j] = xr[64 * j]; }
#pragma unroll
            for (int r = 0; r < 4; ++r) { const int m = m0 + r * NGW; if (m < M) { u32x2* o8 = (u32x2*)(hb + (size_t)m * D) + lane; float s = 0.f;
#pragma unroll
                for (int j = 0; j < 4; ++j) { s += pg8::dot4(v[r][j]); u32x2 w; w.x = cvt_pk_bf16(v[r][j][0], v[r][j][1]); w.y = cvt_pk_bf16(v[r][j][2], v[r][j][3]); o8[64 * j] = w; }
                sq[r] = s; } else sq[r] = 0.f; }
#pragma unroll
            for (int r = 0; r < 4; ++r) { float s = sq[r];
#pragma unroll
                for (int o = 1; o < 64; o <<= 1) s += __shfl_xor(s, o);
                const int m = m0 + r * NGW; if (m < M && lane < 16) ssh[(size_t)m * 16 + lane] = (lane == 0) ? s : 0.f; }
        }
    }
}

template <int W> __device__ __forceinline__ void pool_item(const bf16_t* p, int s, bf16_t* dst) {
    float acc[8], cur[8];
    u32x4 raw[W];
#pragma unroll
    for (int j = 0; j < W; ++j) { const int jj = j <= s ? j : s; raw[j] = *(const u32x4*)(p - (size_t)jj * 1024); }
    unpack8(raw[0], cur);
#pragma unroll
    for (int i = 0; i < 8; ++i) acc[i] = cur[i];
#pragma unroll
    for (int j = 1; j < W; ++j) { float v[8]; unpack8(raw[j], v); const float ok = j <= s ? 1.0f : 0.0f;
#pragma unroll
        for (int i = 0; i < 8; ++i) acc[i] += ok * v[i]; }
    const int cnt = (s + 1 < W) ? (s + 1) : W; const float ic = 1.0f / (float)cnt;
#pragma unroll
    for (int i = 0; i < 8; ++i) acc[i] = acc[i] * ic - cur[i];
    *(u32x4*)dst = pack8(acc);
}
__device__ __forceinline__ void pool_phase(const bf16_t* proj, bf16_t* mix, int G) {
    const int tid = otid(), lane = tid & 63, wid = __builtin_amdgcn_readfirstlane(tid >> 6);
    const int g = wid & 3, tq = wid >> 2, cc = g * 16 + (lane & 15);
    for (int item = blockIdx.x; item < M / 8; item += G) {
        const int tok = item * 8 + tq * 4 + (lane >> 4), s = tok & (SEQ - 1);
        const bf16_t* p = proj + (size_t)tok * 1024 + 416 + cc * 8; bf16_t* dst = mix + (size_t)tok * 1024 + 512 + cc * 8;
        if (g == 0) pool_item<2>(p, s, dst); else if (g == 1) pool_item<4>(p, s, dst); else if (g == 2) pool_item<8>(p, s, dst); else pool_item<16>(p, s, dst);
    }
}

__device__ __forceinline__ void kpost_phase(const bf16_t* qkv, const bf16_t* proj, const float* cstab, const float* kg, bf16_t* KF, int G) {
    const int tid = otid(), sub = tid & 3;
    for (int idx = (blockIdx.x * NTHR + tid) >> 2; idx < M * NH; idx += (G * NTHR) >> 2) {
        const int tok = idx >> 3, h = idx & 7, b = tok / SEQ, s = tok & (SEQ - 1);
        const bf16_t* s0 = qkv + (size_t)tok * 1792 + 768 + h * 128 + 8 * sub; const bf16_t* s1 = proj + (size_t)tok * 1024 + 384 + 8 * sub;
        const float* cs = cstab + (size_t)tok * 32;
        bf16_t* dst = KF + ((size_t)(b * NH + h) * SEQ + s) * 96 + 8 * sub;
        const u32x4 r0 = *(const u32x4*)s0, r1 = *(const u32x4*)(s0 + 32), r2 = *(const u32x4*)s1;
        float v0[8], v1[8], v2[8]; unpack8(r0, v0); unpack8(r1, v1); unpack8(r2, v2);
        float ss = 0.f;
#pragma unroll
        for (int i = 0; i < 8; ++i) ss += v0[i] * v0[i] + v1[i] * v1[i] + v2[i] * v2[i];
        ss += pg8::sxor<1>(ss); ss += pg8::sxor<2>(ss);
        const float rs = __builtin_amdgcn_rsqf(ss * (1.0f / 96.0f) + EPS);
#pragma unroll
        for (int i = 0; i < 8; ++i) { v0[i] = v0[i] * rs * kg[8 * sub + i]; v1[i] = v1[i] * rs * kg[32 + 8 * sub + i]; v2[i] = v2[i] * rs * kg[64 + 8 * sub + i]; }
        *(u32x4*)dst = pack8(v0); *(u32x4*)(dst + 32) = pack8(v1);
        float o[8];
#pragma unroll
        for (int i = 0; i < 8; ++i) { const float other = pg8::sxor<2>(v2[i]); const int j = 8 * (sub & 1) + i; const float co = cs[j], si = cs[16 + j];
            o[i] = (sub < 2) ? (v2[i] * co - other * si) : (other * si + v2[i] * co); }
        *(u32x4*)(dst + 64) = pack8(o);
    }
}

namespace att {
constexpr int KROW = 208, VROW = 192, KBUF = 64 * KROW, VBUF = 64 * VROW, BUFB = KBUF + VBUF;
typedef short v4i16_t __attribute__((ext_vector_type(4)));
#define MFMA32(a, b, c) __builtin_amdgcn_mfma_f32_32x32x16_bf16(a, b, c, 0, 0, 0)
__device__ __forceinline__ void attn_unit(int bh, int qb, const bf16_t* QKV, const bf16_t* KF, const float* cstab, const float* qg, bf16_t* MIX, LAS unsigned char* lds) {
    const int tid = otid(), lane = tid & 63, r32 = lane & 31, hi = lane >> 5, wid = __builtin_amdgcn_readfirstlane(tid >> 6);
    const int b = bh >> 3, h = bh & 7, q0 = qb * 256, qw = q0 + 32 * wid, q = qw + r32;
    bf16x8 qf[6];
    {
        const bf16_t* Qp = QKV + (size_t)(b * SEQ + q) * 1792 + h * 96 + 8 * hi;
        const float* cs = cstab + (size_t)(b * SEQ + q) * 32 + 8 * hi;
        u32x4 raw[6];
#pragma unroll
        for (int d0 = 0; d0 < 6; ++d0) raw[d0] = *(const u32x4*)(Qp + 16 * d0);
        float ss = 0.f;
#pragma unroll
        for (int d0 = 0; d0 < 6; ++d0) { float v[8]; unpack8(raw[d0], v);
#pragma unroll
            for (int i = 0; i < 8; ++i) ss += v[i] * v[i]; }
        ss = pg8::sum32(ss);
        const float rs = __builtin_amdgcn_rsqf(ss * (1.0f / 96.0f) + EPS) * C2Q;
#pragma unroll
        for (int d0 = 0; d0 < 4; ++d0) { float v[8]; unpack8(raw[d0], v);
#pragma unroll
            for (int i = 0; i < 8; ++i) v[i] = v[i] * rs * qg[16 * d0 + 8 * hi + i];
            qf[d0] = __builtin_bit_cast(bf16x8, pack8(v)); }
        float x1[8], x2[8], o1[8], o2[8]; unpack8(raw[4], x1); unpack8(raw[5], x2);
#pragma unroll
        for (int i = 0; i < 8; ++i) { const float y1 = x1[i] * rs * qg[64 + 8 * hi + i], y2 = x2[i] * rs * qg[80 + 8 * hi + i], co = cs[i], si = cs[16 + i];
            o1[i] = y1 * co - y2 * si; o2[i] = y1 * si + y2 * co; }
        qf[4] = __builtin_bit_cast(bf16x8, pack8(o1)); qf[5] = __builtin_bit_cast(bf16x8, pack8(o2));
    }
    const char* Kg = (const char*)(KF + (size_t)bh * SEQ * 96);
    const char* Vg = (const char*)(QKV + (size_t)b * SEQ * 1792 + 768 + h * 128 + 64) + (size_t)(tid >> 3) * 3584 + (tid & 7) * 16;
    const int kofs0 = (tid / 12) * KROW + (tid % 12) * 16, kofs1 = ((tid + 512) / 12) * KROW + ((tid + 512) % 12) * 16, vofs = KBUF + (tid >> 3) * VROW + (tid & 7) * 16;
    const int vtb = KBUF + (4 * hi + ((lane & 15) >> 2)) * VROW + (16 * ((lane >> 4) & 1) + 4 * (lane & 3)) * 2;
    const int NT = 4 * (qb + 1);
    u32x4 kr0, kr1 = {0u, 0u, 0u, 0u}, vr;
#define ATT_LOAD(t) do { kr0 = *(const u32x4*)(Kg + (size_t)(t) * 12288 + tid * 16); if (tid < 256) kr1 = *(const u32x4*)(Kg + (size_t)(t) * 12288 + (tid + 512) * 16); vr = *(const u32x4*)(Vg + (size_t)(t) * (64 * 3584)); } while (0)
#define ATT_WRITE(bufp) do { *(LAS u32x4*)((bufp) + kofs0) = kr0; if (tid < 256) *(LAS u32x4*)((bufp) + kofs1) = kr1; *(LAS u32x4*)((bufp) + vofs) = vr; } while (0)
    float mrun = 0.f, lrun = 0.f;
    f32x16 o0, o1, negm;
#pragma unroll
    for (int r = 0; r < 16; ++r) { o0[r] = 0.f; o1[r] = 0.f; negm[r] = 0.f; }
    ATT_LOAD(0); ATT_WRITE(lds);
    __syncthreads();
    for (int t = 0; t < NT; ++t) {
        LAS unsigned char* buf = lds + (t & 1) * BUFB;
        if (t + 1 < NT) ATT_LOAD(t + 1);
#pragma unroll
        for (int kb = 0; kb < 2; ++kb) {
            const int key0 = 64 * t + 32 * kb;
            if (key0 > qw + 31) continue;
            const LAS unsigned char* kp = buf + (32 * kb + r32) * KROW + 16 * hi;
            f32x16 p = negm;
            bf16x8 kfr[6];
#pragma unroll
            for (int d0 = 0; d0 < 6; ++d0) kfr[d0] = *(const LAS bf16x8*)(kp + 32 * d0);
            __builtin_amdgcn_s_setprio(1);
#pragma unroll
            for (int d0 = 0; d0 < 6; ++d0) p = MFMA32(kfr[d0], qf[d0], p);
            __builtin_amdgcn_s_setprio(0);
            if (key0 + 31 > qw) {
#pragma unroll
                for (int r = 0; r < 16; ++r) { const int key = key0 + (r & 3) + 8 * (r >> 2) + 4 * hi; if (key > q) p[r] = -1e30f; }
            }
            float mx = fmaxf(fmaxf(p[0], p[1]), fmaxf(p[2], p[3]));
#pragma unroll
            for (int r = 4; r < 16; r += 4) mx = fmaxf(mx, fmaxf(fmaxf(p[r], p[r + 1]), fmaxf(p[r + 2], p[r + 3])));
            mx = pg8::max32(mx);
            if (key0 == 0 || __any(mx > 4.0f)) {
                const float dl = (key0 == 0) ? mx : fmaxf(mx, 0.f), f = __builtin_amdgcn_exp2f(-dl);
                mrun += dl; lrun *= f;
#pragma unroll
                for (int r = 0; r < 16; ++r) { o0[r] *= f; o1[r] *= f; p[r] -= dl; negm[r] = -mrun; }
            }
            float ps = 0.f;
#pragma unroll
            for (int r = 0; r < 16; ++r) { p[r] = __builtin_amdgcn_exp2f(p[r]); ps += p[r]; }
            lrun += ps;
            u32x4 w0, w1;
#pragma unroll
            for (int k = 0; k < 4; ++k) { w0[k] = cvt_pk_bf16(p[2 * k], p[2 * k + 1]); w1[k] = cvt_pk_bf16(p[8 + 2 * k], p[8 + 2 * k + 1]); }
            const bf16x8 pb0 = __builtin_bit_cast(bf16x8, w0), pb1 = __builtin_bit_cast(bf16x8, w1);
            const LAS unsigned char* vp = buf + vtb + (32 * kb) * VROW;
#pragma unroll
            for (int db = 0; db < 2; ++db) {
                const v4i16_t a0 = __builtin_amdgcn_ds_read_tr16_b64_v4i16((LAS v4i16_t*)(vp + db * 64));
                const v4i16_t a1 = __builtin_amdgcn_ds_read_tr16_b64_v4i16((LAS v4i16_t*)(vp + db * 64 + 8 * VROW));
                const v4i16_t c0 = __builtin_amdgcn_ds_read_tr16_b64_v4i16((LAS v4i16_t*)(vp + db * 64 + 16 * VROW));
                const v4i16_t c1 = __builtin_amdgcn_ds_read_tr16_b64_v4i16((LAS v4i16_t*)(vp + db * 64 + 24 * VROW));
                const bf16x8 va = {a0[0], a0[1], a0[2], a0[3], a1[0], a1[1], a1[2], a1[3]}, vc = {c0[0], c0[1], c0[2], c0[3], c1[0], c1[1], c1[2], c1[3]};
                __builtin_amdgcn_s_setprio(1);
                if (db == 0) { o0 = MFMA32(va, pb0, o0); o0 = MFMA32(vc, pb1, o0); }
                else { o1 = MFMA32(va, pb0, o1); o1 = MFMA32(vc, pb1, o1); }
                __builtin_amdgcn_s_setprio(0);
            }
        }
        if (t + 1 < NT) { LAS unsigned char* nb = lds + ((t + 1) & 1) * BUFB; ATT_WRITE(nb); }
        __syncthreads();
    }
    const float l = pg8::sum32(lrun), inv = 1.0f / l;
    {
        constexpr int OROW = 144;
        LAS unsigned char* stg = lds + 2 * BUFB + wid * (32 * OROW);
#pragma unroll
        for (int rg = 0; rg < 4; ++rg) {
            u32x2 w; w.x = cvt_pk_bf16(o0[4 * rg] * inv, o0[4 * rg + 1] * inv); w.y = cvt_pk_bf16(o0[4 * rg + 2] * inv, o0[4 * rg + 3] * inv);
            u32x2 x; x.x = cvt_pk_bf16(o1[4 * rg] * inv, o1[4 * rg + 1] * inv); x.y = cvt_pk_bf16(o1[4 * rg + 2] * inv, o1[4 * rg + 3] * inv);
            *(LAS u32x2*)(stg + r32 * OROW + (8 * rg + 4 * hi) * 2) = w; *(LAS u32x2*)(stg + r32 * OROW + (32 + 8 * rg + 4 * hi) * 2) = x;
        }
        asm volatile("s_waitcnt lgkmcnt(0)" ::: "memory");
        bf16_t* dst = MIX + ((size_t)(b * SEQ + qw)) * 1024 + h * 64 + (lane & 7) * 8;
#pragma unroll
        for (int it = 0; it < 4; ++it) { const int row = it * 8 + (lane >> 3); const u32x4 v = *(const LAS u32x4*)(stg + row * OROW + (lane & 7) * 16); *(u32x4*)(dst + (size_t)row * 1024) = v; }
    }
#undef ATT_LOAD
#undef ATT_WRITE
}
__device__ __forceinline__ void attn_phase(const bf16_t* QKV, const bf16_t* KF, const float* cstab, const float* qg, bf16_t* MIX, LAS unsigned char* lds, int G) {
    const int bx = blockIdx.x, vcu = (G % 8 == 0) ? (bx % 8) * (G / 8) + bx / 8 : bx;
    for (int P = vcu; P < 1024; P += G) {
        const int bh = P >> 3, j = P & 7;
        attn_unit(bh, 15 - j, QKV, KF, cstab, qg, MIX, lds);
        attn_unit(bh, j, QKV, KF, cstab, qg, MIX, lds);
    }
}
}

__device__ __forceinline__ void sg_phase(const float* sgw, const float* sgb, const float* sgn, const bf16_t* U, const bf16_t* VTc, const float* ssv, bf16_t* GATED, LAS unsigned char* lds, int G) {
    const int tid = otid(), lane = tid & 63, fr = lane & 15, fq = lane >> 4, wid = __builtin_amdgcn_readfirstlane(tid >> 6);
    constexpr int WROW = 272, TAB_OFF = 36864;
    LAS float* tab = (LAS float*)(lds + TAB_OFF);
    for (int unit = blockIdx.x; unit < 2048; unit += G) {
        const int chunk = unit >> 2, g = unit & 3, tok0 = chunk * 128;
        bf16x8 bfr[2][4];
        const bf16_t* vb = VTc + ((size_t)chunk * 1024 + g * 256 + 32 * wid + 8 * (fr >> 2) + (fr & 3)) * 128 + 8 * fq;
#pragma unroll
        for (int nf = 0; nf < 2; ++nf)
#pragma unroll
            for (int kk = 0; kk < 4; ++kk) bfr[nf][kk] = *(const bf16x8*)(vb + (size_t)nf * 4 * 128 + 32 * kk);
        u32x4 uu[8];
        const size_t rowoff = (size_t)(tok0 + fr) * 1024 + g * 256 + 32 * wid + 8 * fq;
#pragma unroll
        for (int tf = 0; tf < 8; ++tf) uu[tf] = *(const u32x4*)(U + rowoff + (size_t)tf * 16 * 1024);
        if (tid < 128) { const f32x4* p = (const f32x4*)(ssv + (size_t)(tok0 + tid) * 8); tab[tid] = __builtin_amdgcn_rsqf((pg8::hsum4(p[0]) + pg8::hsum4(p[1])) * (1.0f / 1024.0f) + EPS); }
        __syncthreads();
        {
            const int t = tid >> 2, sg0 = 32 * (tid & 3);
            if (sg0 <= t) {
                const float* wrow = sgw + ((size_t)g * 128 + t) * 128 + sg0;
#pragma unroll
                for (int c = 0; c < 4; ++c) { const f32x4 wa = *(const f32x4*)(wrow + 8 * c), wb = *(const f32x4*)(wrow + 8 * c + 4); float av[8];
#pragma unroll
                    for (int j = 0; j < 8; ++j) { const int s = sg0 + 8 * c + j; const float w = j < 4 ? wa[j] : wb[j - 4]; av[j] = (s <= t) ? w * tab[s] : 0.f; }
                    *(LAS u32x4*)(lds + t * WROW + (sg0 + 8 * c) * 2) = pack8(av); }
            }
        }
        __syncthreads();
        f32x4 acc[8][2];
#pragma unroll
        for (int tf = 0; tf < 8; ++tf) { acc[tf][0] = (f32x4){0.f, 0.f, 0.f, 0.f}; acc[tf][1] = (f32x4){0.f, 0.f, 0.f, 0.f}; }
#pragma unroll
        for (int tf = 0; tf < 8; ++tf)
#pragma unroll
            for (int kk = 0; kk < 4; ++kk) if (kk <= (tf >> 1)) {
                const bf16x8 af = *(const LAS bf16x8*)(lds + (16 * tf + fr) * WROW + (32 * kk + 8 * fq) * 2);
                acc[tf][0] = __builtin_amdgcn_mfma_f32_16x16x32_bf16(bfr[0][kk], af, acc[tf][0], 0, 0, 0);
                acc[tf][1] = __builtin_amdgcn_mfma_f32_16x16x32_bf16(bfr[1][kk], af, acc[tf][1], 0, 0, 0);
            }
        const f32x4 gn0 = *(const f32x4*)(sgn + g * 256 + 32 * wid + 8 * fq), gn1 = *(const f32x4*)(sgn + g * 256 + 32 * wid + 8 * fq + 4);
#pragma unroll
        for (int tf = 0; tf < 8; ++tf) {
            const float bias = sgb[g * 128 + 16 * tf + fr];
            float uv[8], ov[8]; unpack8(uu[tf], uv);
#pragma unroll
            for (int i = 0; i < 4; ++i) { ov[i] = uv[i] * (acc[tf][0][i] * gn0[i] + bias); ov[4 + i] = uv[4 + i] * (acc[tf][1][i] * gn1[i] + bias); }
            *(u32x4*)(GATED + rowoff + (size_t)tf * 16 * 1024) = pack8(ov);
        }
        __syncthreads();
    }
}

#define XB_TMO      128
#define XB_XCNT(j)  (256  + 64 * (j))
#define XB_XSUB(j)  (1280 + 64 * (j))
#define XB_XGEN(j)  (2304 + 64 * (j))
#define XB_TOP      3328
#define XB_TOPGEN   3392
#define XCD_BAR_WORDS 3456
#define XB_SPIN_CAP (1u << 18)

__device__ __forceinline__ unsigned xb_ld(unsigned* p)              { return __hip_atomic_load(p, __ATOMIC_RELAXED, __HIP_MEMORY_SCOPE_AGENT); }
__device__ __forceinline__ unsigned xb_add(unsigned* p, unsigned v) { return __hip_atomic_fetch_add(p, v, __ATOMIC_RELAXED, __HIP_MEMORY_SCOPE_AGENT); }
__device__ __forceinline__ unsigned xb_xcc_id() { return (unsigned)__builtin_amdgcn_s_getreg((3 << 11) | 20) & 0xFu; }
#define XB_SPIN(cond, bar) do { unsigned _sp = 0; while (cond) { __builtin_amdgcn_s_sleep(1); \
    if ((++_sp & 255u) == 0u) { if (xb_ld(&(bar)[XB_TMO])) break; if (_sp > XB_SPIN_CAP) { atomicAdd(&(bar)[XB_TMO], 1u); break; } } } } while (0)

struct XcdBarrier {
    unsigned* bar; unsigned x;
    volatile LAS unsigned* st;
};

__device__ __forceinline__ XcdBarrier xcd_barrier_post(unsigned* bar, volatile LAS unsigned* st) {
    XcdBarrier b; b.bar = bar; b.x = xb_xcc_id(); b.st = st;
    if (threadIdx.x == 0) (void)xb_add(&bar[XB_XCNT(b.x)], 1u);
    return b;
}
__device__ __forceinline__ void xcd_barrier_complete(unsigned* bar, unsigned x, unsigned& nloc, unsigned& nx) {
    const unsigned G = gridDim.x * gridDim.y * gridDim.z;
    unsigned sum, cnt, mine, sp = 0u;
    for (;;) {
        sum = 0u; cnt = 0u; mine = 0u;
#pragma unroll
        for (unsigned j = 0; j < 16; ++j) { const unsigned c = xb_ld(&bar[XB_XCNT(j)]); sum += c; cnt += (c > 0u) ? 1u : 0u; mine = (j == x) ? c : mine; }
        if (sum == G) break;
        __builtin_amdgcn_s_sleep(1);
        if ((++sp & 255u) == 0u) { if (xb_ld(&bar[XB_TMO])) break; if (sp > XB_SPIN_CAP) { atomicAdd(&bar[XB_TMO], 1u); break; } }
    }
    nloc = mine > 0u ? mine : 1u; nx = cnt > 0u ? cnt : 1u;
}

__device__ __forceinline__ void xcd_barrier(const XcdBarrier& b) {
    asm volatile("s_waitcnt vmcnt(0)" ::: "memory");
    __syncthreads();
    if (threadIdx.x == 0) {
        unsigned* bar = b.bar;
        __builtin_amdgcn_s_waitcnt(0);
        unsigned nloc = b.st[0], nx = b.st[1];
        if (nloc == 0u) { xcd_barrier_complete(bar, b.x, nloc, nx); b.st[0] = nloc; b.st[1] = nx; }
        const unsigned old = xb_add(&bar[XB_XSUB(b.x)], 1u);
        const unsigned gen = old / nloc;
        if (old + 1u == (gen + 1u) * nloc) {
            __builtin_amdgcn_fence(__ATOMIC_RELEASE, "agent");
            asm volatile("s_waitcnt vmcnt(0)" ::: "memory");
            const unsigned og = xb_add(&bar[XB_TOP], 1u);
            const unsigned tg = og / nx;
            if (og + 1u == (tg + 1u) * nx) xb_add(&bar[XB_TOPGEN], 1u);
            else XB_SPIN(xb_ld(&bar[XB_TOPGEN]) == tg, bar);
            __builtin_amdgcn_fence(__ATOMIC_ACQUIRE, "agent");
            xb_add(&bar[XB_XGEN(b.x)], 1u);
            asm volatile("s_waitcnt vmcnt(0)" ::: "memory");
        } else {
            XB_SPIN(xb_ld(&bar[XB_XGEN(b.x)]) == gen, bar);
            __builtin_amdgcn_fence(__ATOMIC_ACQUIRE, "agent");
            asm volatile("s_waitcnt vmcnt(0)" ::: "memory");
        }
    }
    __syncthreads();
}

__global__ void __launch_bounds__(NTHR, 2) fwd_kernel(Args a) {
    extern __shared__ __attribute__((aligned(16))) unsigned char lds_raw[];
    cg::grid_group grid = cg::this_grid();
    LAS unsigned char* lds = (LAS unsigned char*)lds_raw;
    const int G = gridDim.x;
    if (threadIdx.x < 4) ((LAS unsigned*)(lds + LDS_MISC))[threadIdx.x] = 0u;
    __syncthreads();
    if (blockIdx.x == 0) { unsigned* cw = (unsigned*)(KWS + WS_CTL); for (int i = threadIdx.x; i < (int)(CTL_BYTES / 4); i += NTHR) cw[i] = 0u; }
#define XBAR() do { XcdBarrier xb_; xb_.bar = (unsigned*)(KWS + WS_CTL); xb_.x = xb_xcc_id(); xb_.st = (volatile LAS unsigned*)(lds + LDS_MISC); xcd_barrier(xb_); } while (0)

#ifndef PH_MASK
#define PH_MASK 0xFFFF
#endif
#ifndef RPT_MASK
#define RPT_MASK 0
#endif
#define RPT(x) (((PH_MASK & (x)) ? 1 : 0) + ((RPT_MASK & (x)) ? 1 : 0))
#define REPEAT(x) _Pragma("unroll 1") for (int rp_ = 0; rp_ < RPT(x); ++rp_)
    REPEAT(1) prologue(lds, G);
    grid.sync();
    (void)xcd_barrier_post((unsigned*)(KWS + WS_CTL), (volatile LAS unsigned*)(lds + LDS_MISC));

#pragma unroll 1
    for (int L = 0; L < 4; ++L) {
#pragma unroll 1
        for (int st = 0; st < 3; ++st) {
            unsigned char* ws = KWS; float* out = KOUT;
            float* ssh = (float*)(ws + WS_SSH); float* ssq = (float*)(ws + WS_SSQ); float* sskv = (float*)(ws + WS_SSKV); float* ssv = (float*)(ws + WS_SSV);
            const float* cstab = (const float*)(ws + WS_CS);
            bf16_t* HB = (bf16_t*)(ws + WS_HB);
            bf16_t* HID = (bf16_t*)(ws + WS_A); bf16_t* PROJ = (bf16_t*)(ws + WS_A); bf16_t* KF = (bf16_t*)(ws + WS_A + 224 * MiB);
            bf16_t* UU = (bf16_t*)(ws + WS_A); bf16_t* VTC = (bf16_t*)(ws + WS_A + 128 * MiB);
            bf16_t* QKV = (bf16_t*)(ws + WS_B); bf16_t* GATED = (bf16_t*)(ws + WS_B);
            bf16_t* MIX = (bf16_t*)(ws + WS_MIX);
            if (st != 1) {
                const int f = 2 * L + (st >> 1);
                const bf16_t* wgu = (const bf16_t*)(ws + WS_W + (size_t)f * FFN_W_BYTES); const bf16_t* wd = wgu + (size_t)5632 * 1024;
                {
                    pg8::Gemm g{HB, wgu, M, 5632, 1024, 1024, 1024}; pg8::StaticOrder S; S.init(M, 5632, G, (int)blockIdx.x);
                    pg8::EpiSwiGLU E{HID, ssh, FF};
                    REPEAT(2) pg8::gemm_phase<pg8::EpiSwiGLU, pg8::StaticOrder, true, true>(lds, g, S, E);
                }
                XBAR();
                {
                    pg8::Gemm g{HID, wd, M, 1024, FF, FF, FF}; pg8::StaticOrder S; S.init(M, 1024, G, (int)blockIdx.x);
                    pg8::EpiResid E{nullptr, (L == 3 && st == 2) ? out : nullptr, HB, ssh, 0.5f};
                    REPEAT(4) { pg8::EpiResid E2 = E; if (rp_ + 1 < RPT(4) && !E.xf) E2.alpha = 0.f; pg8::gemm_phase<pg8::EpiResid, pg8::StaticOrder, true, true>(lds, g, S, E2); }
                }
                XBAR();
            } else if ((L & 1) == 0) {
                const int e = L >> 1;
                const bf16_t* win = (const bf16_t*)(ws + WS_EVEN + (size_t)e * 6 * MiB); const bf16_t* wqkv = win + 1024 * 1024; const bf16_t* wout = (const bf16_t*)(ws + WS_EVEN + (size_t)e * 6 * MiB + 4 * MiB);
                {
                    pg8::Gemm g{HB, win, M, 1024, 1024, 1024, 1024}; pg8::StaticOrder S; S.init(M, 1024, G, (int)blockIdx.x);
                    pg8::EpiRowBf16<2> E{PROJ, 1024, ssh, ssq, sskv};
                    REPEAT(8) pg8::gemm_phase<pg8::EpiRowBf16<2>, pg8::StaticOrder, true, true>(lds, g, S, E);
                }
                XBAR();
                {
                    pg8::Gemm g{PROJ, wqkv, M, 1792, 384, 1024, 384}; pg8::QkvOrder S; S.init(M, 1792, G, (int)blockIdx.x);
                    pg8::EpiQKV E{QKV, 1792, ssq, sskv};
                    REPEAT(16) pg8::gemm_phase<pg8::EpiQKV, pg8::QkvOrder, true, true>(lds, g, S, E);
                    REPEAT(32) pool_phase(PROJ, MIX, G);
                }
                XBAR();
                REPEAT(64) kpost_phase(QKV, PROJ, cstab, KIN(13) + e * 96, KF, G);
                XBAR();
                REPEAT(128) att::attn_phase(QKV, KF, cstab, KIN(12) + e * 96, MIX, lds, G);
                XBAR();
                {
                    pg8::Gemm g{MIX, wout, M, 1024, 1024, 1024, 1024}; pg8::StaticOrder S; S.init(M, 1024, G, (int)blockIdx.x);
                    pg8::EpiResid E{nullptr, nullptr, HB, ssh, 1.0f};
                    REPEAT(2048) { pg8::EpiResid E2 = E; if (rp_ + 1 < RPT(2048)) E2.alpha = 0.f; pg8::gemm_phase<pg8::EpiResid, pg8::StaticOrder, true, true>(lds, g, S, E2); }
                }
                XBAR();
            } else {
                const int o = L >> 1;
                const bf16_t* wu = (const bf16_t*)(ws + WS_ODD + (size_t)o * 6 * MiB); const bf16_t* wv = wu + 1024 * 1024; const bf16_t* wout = wv + 1024 * 1024;
                {
                    pg8::Gemm g{HB, wu, M, 1024, 1024, 1024, 1024}; pg8::StaticOrder S; S.init(M, 1024, G, (int)blockIdx.x);
                    pg8::EpiRowBf16<1> E{UU, 1024, ssh, nullptr, nullptr};
                    REPEAT(256) pg8::gemm_phase<pg8::EpiRowBf16<1>, pg8::StaticOrder, true, true>(lds, g, S, E);
                }
                {
                    pg8::Gemm g{wv, HB, 1024, M, 1024, 1024, 1024}; pg8::StaticOrder S; S.init(1024, M, G, (int)blockIdx.x);
                    pg8::EpiVt E{VTC, ssh, ssv};
                    REPEAT(512) pg8::gemm_phase<pg8::EpiVt, pg8::StaticOrder, true, true>(lds, g, S, E);
                }
                XBAR();
                REPEAT(1024) sg_phase(KIN(19) + (size_t)o * 4 * 128 * 128, KIN(20) + o * 4 * 128, KIN(18) + o * 1024, UU, VTC, ssv, GATED, lds, G);
                XBAR();
                {
                    pg8::Gemm g{GATED, wout, M, 1024, 1024, 1024, 1024}; pg8::StaticOrder S; S.init(M, 1024, G, (int)blockIdx.x);
                    pg8::EpiResid E{nullptr, nullptr, HB, ssh, 1.0f};
                    REPEAT(2048) { pg8::EpiResid E2 = E; if (rp_ + 1 < RPT(2048)) E2.alpha = 0.f; pg8::gemm_phase<pg8::EpiResid, pg8::StaticOrder, true, true>(lds, g, S, E2); }
                }
                XBAR();
            }
        }
    }
}

extern "C" void kernel_launch(void* const* d_in, const int* in_sizes, int n_in, void* d_out, int out_size, void* d_ws, size_t ws_size, hipStream_t stream) {
    static int grid = 0;
    if (grid == 0) {
        if (n_in != 22 || out_size != M * D || ws_size < WS_END) { fprintf(stderr, "kernel_launch: unexpected shapes (n_in %d out %d ws %zu)\n", n_in, out_size, ws_size); grid = -1; return; }
        int dev = 0, cus = 0, per_cu = 0;
        if (hipGetDevice(&dev) != hipSuccess || hipDeviceGetAttribute(&cus, hipDeviceAttributeMultiprocessorCount, dev) != hipSuccess) { grid = -1; return; }
        if (hipFuncSetAttribute((const void*)fwd_kernel, hipFuncAttributeMaxDynamicSharedMemorySize, LDS_BYTES) != hipSuccess) { fprintf(stderr, "kernel_launch: hipFuncSetAttribute failed\n"); grid = -1; return; }
        if (hipOccupancyMaxActiveBlocksPerMultiprocessor(&per_cu, (const void*)fwd_kernel, NTHR, LDS_BYTES) != hipSuccess || per_cu < 1) fprintf(stderr, "kernel_launch: occupancy query reports %d\n", per_cu);
        (void)hipGetLastError();
        grid = cus;
    }
    if (grid < 0) return;
    Args a{};
    for (int i = 0; i < 22; ++i) a.in[i] = (const float*)d_in[i];
    a.out = (float*)d_out; a.ws = (unsigned char*)d_ws;
    void* args[] = {&a};
    hipError_t e = hipLaunchCooperativeKernel((const void*)fwd_kernel, dim3(grid), dim3(NTHR), args, LDS_BYTES, stream);
    if (e != hipSuccess) fprintf(stderr, "kernel_launch: cooperative launch failed: %s\n", hipGetErrorString(e));
}
```

```cpp
#include <hip/hip_runtime.h>
#include <hip/hip_cooperative_groups.h>
#include <cstdio>
#include <cstdint>
namespace cg = cooperative_groups;

namespace pg8 {
#define PG8_LAS __attribute__((address_space(3)))
typedef unsigned short bf16_t;
typedef short bf16x8 __attribute__((ext_vector_type(8)));
typedef float f32x4 __attribute__((ext_vector_type(4)));
typedef float f32x16 __attribute__((ext_vector_type(16)));
typedef unsigned u32x4 __attribute__((ext_vector_type(4)));
typedef unsigned u32x2 __attribute__((ext_vector_type(2)));
constexpr int BM = 256, BK = 64, HALF = 128, HTB = HALF * BK * 2  , STAGE_BYTES = 8 * HTB, NXCD = 8, WGM = 4;

__host__ __device__ __forceinline__ int lds_byte(int r, int c) { const int st = (r >> 4) * 2 + (c >> 5), rr = r & 15, cc = c & 31, ob = rr * 64 + cc * 2; return st * 1024 + (ob ^ (((ob >> 9) & 1) << 5)); }
__host__ __device__ __forceinline__ void stage_rc(int b, int& R, int& C) { const int st = b / 1024, sb = b % 1024, swz = sb ^ (((sb >> 9) & 1) << 5); R = (st >> 1) * 16 + swz / 64; C = (st & 1) * 32 + (swz % 64) / 2; }
__host__ __device__ __forceinline__ int perm32(int rho) { const int n = rho >> 4, i = rho & 15; return 8 * (i >> 2) + 4 * n + (i & 3); }

struct Unit { int pm, pn; };
struct Gemm { const bf16_t* A; const bf16_t* Bt; int M, N, K, lda, ldb; };

struct StaticOrder {
    int nM, nN, nwg, G, c;
    __host__ __device__ void init(int M, int N, int G_, int c_) { nM = M / BM; nN = N / BM; nwg = nM * nN; G = G_; c = c_; }
    __host__ __device__ bool next(int i, Unit& u) const {
        const long L = (long)i * G + c; if (L >= nwg) return false;
        int wgid = (int)L; { const int q = nwg / NXCD, r = nwg % NXCD, xcd = wgid % NXCD, off = wgid / NXCD; wgid = (xcd < r ? xcd * (q + 1) : r * (q + 1) + (xcd - r) * q) + off; }
        const int nig = WGM * nN, gid = wgid / nig, fm = gid * WGM, gsz = (nM - fm) < WGM ? (nM - fm) : WGM;
        u.pm = fm + ((wgid % nig) % gsz); u.pn = (wgid % nig) / gsz; return true;
    }
    __device__ __forceinline__ void a_ready(const Unit&) const {}
    __device__ __forceinline__ void done(const Unit&) const {}
    __device__ __forceinline__ int kt0(const Unit&) const { return 0; }
    __device__ __forceinline__ int ktn(const Unit&, int nt) const { return nt; }
};
struct QkvOrder : StaticOrder {
    __device__ __forceinline__ int kt0(const Unit& u) const { return u.pn < 3 ? 0 : 4; }
    __device__ __forceinline__ int ktn(const Unit& u, int) const { return u.pn < 3 ? 4 : 2; }
};

typedef float f32x2c_ __attribute__((ext_vector_type(2))); typedef __bf16 bf16x2c_ __attribute__((ext_vector_type(2)));
__device__ __forceinline__ unsigned cvt_pk_bf16(float lo, float hi) { const f32x2c_ v = {lo, hi}; const bf16x2c_ b = __builtin_convertvector(v, bf16x2c_); return __builtin_bit_cast(unsigned, b); }
constexpr float EPS = 1e-6f;
template <int N> __device__ __forceinline__ float sxor(float v) { static_assert(N > 0 && N < 32, "sxor"); return __int_as_float(__builtin_amdgcn_ds_swizzle(__float_as_int(v), 0x1f | (N << 10))); }
__device__ __forceinline__ float sum32(float v) { const auto rr = __builtin_amdgcn_permlane32_swap(__float_as_uint(v), __float_as_uint(v), false, false); return __uint_as_float(rr[0]) + __uint_as_float(rr[1]); }
__device__ __forceinline__ float max32(float v) { const auto rr = __builtin_amdgcn_permlane32_swap(__float_as_uint(v), __float_as_uint(v), false, false); return fmaxf(__uint_as_float(rr[0]), __uint_as_float(rr[1])); }
__device__ __forceinline__ float hsum4(f32x4 a) { return (a[0] + a[1]) + (a[2] + a[3]); }
__device__ __forceinline__ float dot4(f32x4 a) { return (a[0] * a[0] + a[1] * a[1]) + (a[2] * a[2] + a[3] * a[3]); }
__device__ __forceinline__ float rstd16(const float* ss, int row, float invn, int fq) {
    const f32x4 a = ((const f32x4*)(ss + (size_t)row * 16))[fq];
    float s = hsum4(a); s += sxor<16>(s); s = sum32(s);
    return __builtin_amdgcn_rsqf(s * invn + EPS);
}
__device__ __forceinline__ float rstd16_full(const float* ss, int row, float invn) {
    const f32x4* p = (const f32x4*)(ss + (size_t)row * 16);
    const f32x4 a = p[0], b = p[1], c = p[2], d = p[3];
    const float s = (hsum4(a) + hsum4(b)) + (hsum4(c) + hsum4(d));
    return __builtin_amdgcn_rsqf(s * invn + EPS);
}
__device__ __forceinline__ float gelu_tanh(float x) {
    const float t = x * (1.5957691216057308f + 0.07135481627f * x * x);
    return x * __builtin_amdgcn_rcpf(1.0f + __builtin_amdgcn_exp2f(-1.4426950408889634f * t));
}

typedef float f32x2 __attribute__((ext_vector_type(2)));
__device__ __forceinline__ void stat_issue(const float* ss, const Unit& u, int wr, int fr, int fq, f32x4 (&raw)[8]) {
#pragma unroll
    for (int ai = 0; ai < 2; ++ai)
#pragma unroll
        for (int m = 0; m < 4; ++m) raw[ai * 4 + m] = ((const f32x4*)(ss + (size_t)(u.pm * BM + ai * HALF + wr * 64 + m * 16 + fr) * 16))[fq];
}
__device__ __forceinline__ void stat_finish(const f32x4 (&raw)[8], float (&rs)[8], float invn) {
#pragma unroll
    for (int r = 0; r < 8; ++r) { float s = hsum4(raw[r]); s += sxor<16>(s); s = sum32(s); rs[r] = __builtin_amdgcn_rsqf(s * invn + EPS); }
}
__device__ __forceinline__ f32x2 sigmoid_pk(f32x2 t) {
    const f32x2 a = t * (-1.4426950408889634f); f32x2 e; e.x = __builtin_amdgcn_exp2f(a.x); e.y = __builtin_amdgcn_exp2f(a.y);
    const f32x2 d = e + 1.0f; f32x2 r; r.x = __builtin_amdgcn_rcpf(d.x); r.y = __builtin_amdgcn_rcpf(d.y); return r;
}
__device__ __forceinline__ f32x2 gelu_tanh_pk(f32x2 x) { const f32x2 t = x * (x * x * 0.07135481627f + 1.5957691216057308f); return x * sigmoid_pk(t); }
struct EpiSwiGLU {
    static constexpr bool PERM = true, AFTER_DRAIN = false, PRE = true;
    bf16_t* hid; const float* ss; int ldh;
    __device__ __forceinline__ void pre_issue(const Unit& u, int wr, int fr, int fq, f32x4 (&raw)[8]) const { stat_issue(ss, u, wr, fr, fq, raw); }
    __device__ __forceinline__ void pre_finish(const f32x4 (&raw)[8], float (&rs)[8]) const { stat_finish(raw, rs, 1.0f / 1024.0f); }
    __device__ __forceinline__ void operator()(const f32x4 (&acc)[2][2][4][2], const Unit& u, int wr, int wc, int fr, int fq, const float (&rsv)[8]) const {
#pragma unroll
        for (int ai = 0; ai < 2; ++ai)
#pragma unroll
            for (int m = 0; m < 4; ++m) {
                const int row = u.pm * BM + ai * HALF + wr * 64 + m * 16 + fr;
                const float rs = rsv[ai * 4 + m];
                u32x4 w;
#pragma unroll
                for (int n = 0; n < 2; ++n) {
                    const f32x4 g = acc[ai][0][m][n] * rs, up = acc[ai][1][m][n] * rs;
                    const f32x2 g0 = {g[0], g[1]}, g1 = {g[2], g[3]}, u0 = {up[0], up[1]}, u1 = {up[2], up[3]};
                    const f32x2 h0 = (g0 * u0) * sigmoid_pk(g0), h1 = (g1 * u1) * sigmoid_pk(g1);
                    w[2 * n] = cvt_pk_bf16(h0.x, h0.y); w[2 * n + 1] = cvt_pk_bf16(h1.x, h1.y);
                }
                *(u32x4*)(hid + (size_t)row * ldh + u.pn * 128 + wc * 32 + 8 * fq) = w;
            }
    }
};
struct EpiResid {
    static constexpr bool PERM = true, AFTER_DRAIN = false, PRE = false;
    const float* xf; float* outf; bf16_t* hb; float* ss; float alpha;
    __device__ __forceinline__ void pre_issue(const Unit&, int, int, int, f32x4 (&)[8]) const {}
    __device__ __forceinline__ void pre_finish(const f32x4 (&)[8], float (&)[8]) const {}
    __device__ __forceinline__ void operator()(const f32x4 (&acc)[2][2][4][2], const Unit& u, int wr, int wc, int fr, int fq, const float (&)[8]) const {
        const size_t off0 = (size_t)(u.pm * BM + wr * 64 + fr) * 1024 + u.pn * BM + wc * 32 + 8 * fq;
        u32x4 raw[8][2];
        if (!xf) {
#pragma unroll
            for (int r = 0; r < 8; ++r)
#pragma unroll
                for (int bj = 0; bj < 2; ++bj) raw[r][bj] = *(const u32x4*)(hb + off0 + (size_t)(r >> 2) * (HALF * 1024) + (size_t)(r & 3) * (16 * 1024) + bj * HALF);
        }
#pragma unroll
        for (int ai = 0; ai < 2; ++ai)
#pragma unroll
            for (int m = 0; m < 4; ++m) {
                const int row = u.pm * BM + ai * HALF + wr * 64 + m * 16 + fr; float sq = 0.f;
#pragma unroll
                for (int bj = 0; bj < 2; ++bj) {
                    const size_t off = off0 + (size_t)ai * (HALF * 1024) + (size_t)m * (16 * 1024) + bj * HALF;
                    f32x4 b0, b1;
                    if (xf) { b0 = *(const f32x4*)(xf + off); b1 = *(const f32x4*)(xf + off + 4); }
                    else { const u32x4 w = raw[ai * 4 + m][bj];
                        b0[0] = __uint_as_float(w.x << 16); b0[1] = __uint_as_float(w.x & 0xffff0000u); b0[2] = __uint_as_float(w.y << 16); b0[3] = __uint_as_float(w.y & 0xffff0000u);
                        b1[0] = __uint_as_float(w.z << 16); b1[1] = __uint_as_float(w.z & 0xffff0000u); b1[2] = __uint_as_float(w.w << 16); b1[3] = __uint_as_float(w.w & 0xffff0000u); }
                    const f32x4 o0 = b0 + acc[ai][bj][m][0] * alpha, o1 = b1 + acc[ai][bj][m][1] * alpha;
                    if (outf) { *(f32x4*)(outf + off) = o0; *(f32x4*)(outf + off + 4) = o1; }
                    sq += dot4(o0) + dot4(o1);
                    u32x4 w; w.x = cvt_pk_bf16(o0[0], o0[1]); w.y = cvt_pk_bf16(o0[2], o0[3]); w.z = cvt_pk_bf16(o1[0], o1[1]); w.w = cvt_pk_bf16(o1[2], o1[3]);
                    *(u32x4*)(hb + off) = w;
                }
                sq += sxor<16>(sq); sq = sum32(sq);
                if (fq == 0) ss[(size_t)row * 16 + u.pn * 4 + wc] = sq;
            }
    }
};
template <int MODE> struct EpiRowBf16 {
    static constexpr bool PERM = true, AFTER_DRAIN = false, PRE = true;
    bf16_t* O; int ldc; const float* ss; float* ssq; float* sskv;
    __device__ __forceinline__ void pre_issue(const Unit& u, int wr, int fr, int fq, f32x4 (&raw)[8]) const { stat_issue(ss, u, wr, fr, fq, raw); }
    __device__ __forceinline__ void pre_finish(const f32x4 (&raw)[8], float (&rs)[8]) const { stat_finish(raw, rs, 1.0f / 1024.0f); }
    __device__ __forceinline__ void operator()(const f32x4 (&acc)[2][2][4][2], const Unit& u, int wr, int wc, int fr, int fq, const float (&rsv)[8]) const {
#pragma unroll
        for (int ai = 0; ai < 2; ++ai)
#pragma unroll
            for (int m = 0; m < 4; ++m) {
                const int row = u.pm * BM + ai * HALF + wr * 64 + m * 16 + fr;
                const float rs = rsv[ai * 4 + m]; float sq = 0.f;
#pragma unroll
                for (int bj = 0; bj < 2; ++bj) {
                    f32x4 v0 = acc[ai][bj][m][0] * rs, v1 = acc[ai][bj][m][1] * rs;
                    if (MODE == 1) {
                        const f32x2 a = gelu_tanh_pk((f32x2){v0[0], v0[1]}), b = gelu_tanh_pk((f32x2){v0[2], v0[3]}), c = gelu_tanh_pk((f32x2){v1[0], v1[1]}), d = gelu_tanh_pk((f32x2){v1[2], v1[3]});
                        v0 = (f32x4){a.x, a.y, b.x, b.y}; v1 = (f32x4){c.x, c.y, d.x, d.y};
                    }
                    if (MODE == 2) { if (u.pn == 0 || bj == 0) sq += dot4(v0) + dot4(v1); }
                    u32x4 w; w.x = cvt_pk_bf16(v0[0], v0[1]); w.y = cvt_pk_bf16(v0[2], v0[3]); w.z = cvt_pk_bf16(v1[0], v1[1]); w.w = cvt_pk_bf16(v1[2], v1[3]);
                    *(u32x4*)(O + (size_t)row * ldc + u.pn * BM + bj * HALF + wc * 32 + 8 * fq) = w;
                }
                if (MODE == 2) {
                    sq += sxor<16>(sq); sq = sum32(sq);
                    if (fq == 0) { if (u.pn == 0) ssq[(size_t)row * 4 + wc] = sq; else if (u.pn == 1) sskv[(size_t)row * 4 + wc] = sq; }
                }
            }
    }
};
struct EpiQKV {
    static constexpr bool PERM = true, AFTER_DRAIN = false, PRE = true;
    bf16_t* O; int ldc; const float* ssq; const float* sskv;
    __device__ __forceinline__ void pre_issue(const Unit& u, int wr, int fr, int fq, f32x4 (&raw)[8]) const {
        const bool isq = u.pn < 3; const float* ssp = isq ? ssq : sskv; const float invn = isq ? 1.0f / 256.0f : 1.0f / 128.0f;
#pragma unroll
        for (int r = 0; r < 8; ++r) raw[r][0] = ssp[(size_t)(u.pm * BM + (r >> 2) * HALF + wr * 64 + (r & 3) * 16 + fr) * 4 + fq];
        raw[0][1] = invn;
    }
    __device__ __forceinline__ void pre_finish(const f32x4 (&raw)[8], float (&rs)[8]) const {
#pragma unroll
        for (int r = 0; r < 8; ++r) { float sp = raw[r][0]; sp += sxor<16>(sp); sp = sum32(sp); rs[r] = __builtin_amdgcn_rsqf(sp * raw[0][1] + EPS); }
    }
    __device__ __forceinline__ void operator()(const f32x4 (&acc)[2][2][4][2], const Unit& u, int wr, int wc, int fr, int fq, const float (&rsv)[8]) const {
#pragma unroll
        for (int ai = 0; ai < 2; ++ai)
#pragma unroll
            for (int m = 0; m < 4; ++m) {
                const int row = u.pm * BM + ai * HALF + wr * 64 + m * 16 + fr;
                const float rs = rsv[ai * 4 + m];
#pragma unroll
                for (int bj = 0; bj < 2; ++bj) {
                    const f32x4 v0 = acc[ai][bj][m][0] * rs, v1 = acc[ai][bj][m][1] * rs;
                    u32x4 w; w.x = cvt_pk_bf16(v0[0], v0[1]); w.y = cvt_pk_bf16(v0[2], v0[3]); w.z = cvt_pk_bf16(v1[0], v1[1]); w.w = cvt_pk_bf16(v1[2], v1[3]);
                    *(u32x4*)(O + (size_t)row * ldc + u.pn * BM + bj * HALF + wc * 32 + 8 * fq) = w;
                }
            }
    }
};
struct EpiVt {
    static constexpr bool PERM = true, AFTER_DRAIN = false, PRE = false;
    bf16_t* vT; const float* ss; float* ssv;
    __device__ __forceinline__ void pre_issue(const Unit&, int, int, int, f32x4 (&)[8]) const {}
    __device__ __forceinline__ void pre_finish(const f32x4 (&)[8], float (&)[8]) const {}
    __device__ __forceinline__ void operator()(const f32x4 (&acc)[2][2][4][2], const Unit& u, int wr, int wc, int fr, int fq, const float (&)[8]) const {
#pragma unroll
        for (int bj = 0; bj < 2; ++bj) {
            const int tok0 = u.pn * BM + bj * HALF + wc * 32 + 8 * fq;
            float rs[8], sq[8];
            {
                const f32x4* pp = (const f32x4*)(ss + (size_t)(tok0 + (fr >> 1)) * 16 + (fr & 1) * 8);
                float sp = hsum4(pp[0]) + hsum4(pp[1]); sp += sxor<1>(sp);
                const float rv = __builtin_amdgcn_rsqf(sp * (1.0f / 1024.0f) + EPS);
                const int lbase = (fq << 4);
#pragma unroll
                for (int t = 0; t < 8; ++t) { rs[t] = __shfl(rv, lbase + 2 * t); sq[t] = 0.f; }
            }
            const size_t cbase = (size_t)(tok0 >> 7) * (1024 * 128) + (tok0 & 127);
#pragma unroll
            for (int ai = 0; ai < 2; ++ai)
#pragma unroll
                for (int m = 0; m < 4; ++m) {
                    const int c = u.pm * BM + ai * HALF + wr * 64 + m * 16 + fr;
                    float v[8];
#pragma unroll
                    for (int t = 0; t < 8; t += 2) { const f32x2 y = gelu_tanh_pk((f32x2){acc[ai][bj][m][t >> 2][t & 3] * rs[t], acc[ai][bj][m][t >> 2][(t & 3) + 1] * rs[t + 1]}); v[t] = y.x; v[t + 1] = y.y; sq[t] += y.x * y.x; sq[t + 1] += y.y * y.y; }
                    u32x4 w; w.x = cvt_pk_bf16(v[0], v[1]); w.y = cvt_pk_bf16(v[2], v[3]); w.z = cvt_pk_bf16(v[4], v[5]); w.w = cvt_pk_bf16(v[6], v[7]);
                    *(u32x4*)(vT + cbase + (size_t)c * 128) = w;
                }
#pragma unroll
            for (int t = 0; t < 8; ++t) {
                float s = sq[t]; s += sxor<1>(s); s += sxor<2>(s); s += sxor<4>(s); s += sxor<8>(s);
                if (fr == 0) ssv[(size_t)(tok0 + t) * 8 + u.pm * 2 + wr] = s;
            }
        }
    }
};

template <class Epi, class Sched, bool ALIGN_EPI = false, bool SP2 = false>
__device__ __forceinline__ void gemm_phase(PG8_LAS unsigned char* lds, const Gemm g, const Sched& S, const Epi& E) {
    int tid_ = threadIdx.x; asm volatile("" : "+v"(tid_));
    const int tid = tid_, wid = __builtin_amdgcn_readfirstlane(tid >> 6), lane = tid & 63, wr = wid >> 2, wc = wid & 3, fr = lane & 15, fq = lane >> 4;
    int K_ = g.K; asm volatile("" : "+s"(K_));
    const int K = K_, nt = K / BK;
    unsigned voffA[2], voffB[2];
#pragma unroll
    for (int i = 0; i < 2; ++i) { int R, C; stage_rc(tid * 16 + i * 8192, R, C); const int Rb = Epi::PERM ? ((R & ~31) + perm32(R & 31)) : R;
        voffA[i] = (unsigned)(R * g.lda + C) * 2u; voffB[i] = (unsigned)(Rb * g.ldb + C) * 2u; }
    const size_t kstep = (size_t)(BK * 2);
    const size_t hstepA = (size_t)HALF * g.lda * 2, hstepB = (size_t)HALF * g.ldb * 2;
    const size_t tstepA = 2 * hstepA, tstepB = 2 * hstepB;
    const unsigned ldsw = (unsigned)wid * 1024u;
    const int aoff = lds_byte(wr * 64 + fr, fq * 8), boff = lds_byte(wc * 32 + fr, fq * 8);
#define PG8_SA(b, h) (((b) * 2 + (h)) * HTB)
#define PG8_SB(b, h) ((4 + (b) * 2 + (h)) * HTB)
#define PG8_STAGE(bufoff, gbase, voff) do { _Pragma("unroll") for (int _i = 0; _i < 2; ++_i) \
        __builtin_amdgcn_global_load_lds((const unsigned*)((const char*)(gbase) + (voff)[_i]), (PG8_LAS unsigned*)(lds + (bufoff) + ldsw + _i * 8192), 16, 0, 0); } while (0)
#define PG8_LDA(dst, b, h) do { _Pragma("unroll") for (int m = 0; m < 4; ++m) _Pragma("unroll") for (int k = 0; k < 2; ++k) dst[m][k] = *(const PG8_LAS bf16x8*)(lds + PG8_SA(b, h) + aoff + m * 2048 + k * 1024); } while (0)
#define PG8_LDB(dst, b, h) do { _Pragma("unroll") for (int n = 0; n < 2; ++n) _Pragma("unroll") for (int k = 0; k < 2; ++k) dst[n][k] = *(const PG8_LAS bf16x8*)(lds + PG8_SB(b, h) + boff + n * 2048 + k * 1024); } while (0)
#define PG8_MMA(ai, bj, At, Bt) do { __builtin_amdgcn_s_setprio(1); _Pragma("unroll") for (int m = 0; m < 4; ++m) _Pragma("unroll") for (int n = 0; n < 2; ++n) _Pragma("unroll") for (int k = 0; k < 2; ++k) \
        acc[ai][bj][m][n] = __builtin_amdgcn_mfma_f32_16x16x32_bf16(Bt[n][k], At[m][k], acc[ai][bj][m][n], 0, 0, 0); __builtin_amdgcn_s_setprio(0); } while (0)
#define PG8_WAIT_V(n) asm volatile("s_waitcnt vmcnt(" #n ")" ::: "memory")
#define PG8_WAIT_L(n) asm volatile("s_waitcnt lgkmcnt(" #n ")" ::: "memory")
#define PG8_BAR __builtin_amdgcn_s_barrier()
#define PG8_SCHED __builtin_amdgcn_sched_barrier(0)
    Unit cur, nxt; int ui = 0;
    if (!S.next(0, cur)) return;
    float rs_[8];
#pragma unroll
    for (int r = 0; r < 8; ++r) rs_[r] = 0.f;
    if constexpr (Epi::PRE) { f32x4 raw0_[8]; E.pre_issue(cur, wr, fr, fq, raw0_); E.pre_finish(raw0_, rs_); }
    f32x4 acc[2][2][4][2];
#pragma unroll
    for (int a = 0; a < 2; ++a)
#pragma unroll
        for (int b = 0; b < 2; ++b)
#pragma unroll
            for (int m = 0; m < 4; ++m)
#pragma unroll
                for (int n = 0; n < 2; ++n) acc[a][b][m][n] = (f32x4){0.f, 0.f, 0.f, 0.f};
    bf16x8 At[4][2], B0[2][2], B1[2][2];
    const char* cA = (const char*)g.A + (size_t)cur.pm * tstepA + (size_t)S.kt0(cur) * (BK * 2); const char* cB = (const char*)g.Bt + (size_t)cur.pn * tstepB + (size_t)S.kt0(cur) * (BK * 2);
    int ntc = S.ktn(cur, nt);
    S.a_ready(cur);
    if constexpr (SP2) {
        PG8_STAGE(PG8_SB(0, 0), cB, voffB); PG8_STAGE(PG8_SB(0, 1), cB + hstepB, voffB); PG8_STAGE(PG8_SA(0, 0), cA, voffA); PG8_STAGE(PG8_SA(0, 1), cA + hstepA, voffA);
        if (wr == 1) PG8_BAR;
        PG8_WAIT_V(2); PG8_BAR;
        PG8_STAGE(PG8_SB(1, 0), cB + kstep, voffB); PG8_STAGE(PG8_SA(1, 0), cA + kstep, voffA); PG8_STAGE(PG8_SB(1, 1), cB + hstepB + kstep, voffB);
        PG8_WAIT_V(6); PG8_BAR;
    } else {
        PG8_STAGE(PG8_SB(0, 0), cB, voffB); PG8_STAGE(PG8_SA(0, 0), cA, voffA); PG8_STAGE(PG8_SB(0, 1), cB + hstepB, voffB); PG8_STAGE(PG8_SA(0, 1), cA + hstepA, voffA);
        if (wr == 1) PG8_BAR;
        PG8_WAIT_V(4); PG8_BAR;
        PG8_STAGE(PG8_SB(1, 0), cB + kstep, voffB); PG8_STAGE(PG8_SA(1, 0), cA + kstep, voffA); PG8_STAGE(PG8_SB(1, 1), cB + hstepB + kstep, voffB);
        PG8_WAIT_V(6); PG8_BAR;
    }
    for (;;) {
        const bool has_next = S.next(ui + 1, nxt);
        const char* nA = has_next ? (const char*)g.A + (size_t)nxt.pm * tstepA + (size_t)S.kt0(nxt) * (BK * 2) : cA; const char* nB = has_next ? (const char*)g.Bt + (size_t)nxt.pn * tstepB + (size_t)S.kt0(nxt) * (BK * 2) : cB;
        for (int t = 0; t < ntc; t += 2) {
            const bool last = (t == ntc - 2);
            const char* a1 = cA + (size_t)(t + 1) * kstep;
            const char* a2 = last ? nA : cA + (size_t)(t + 2) * kstep; const char* b2 = last ? nB : cB + (size_t)(t + 2) * kstep;
            const char* a3 = a2 + kstep; const char* b3 = b2 + kstep;
            if (last && has_next) S.a_ready(nxt);
            if constexpr (SP2) {
            PG8_LDB(B0, 0, 0); PG8_LDB(B1, 0, 1); PG8_SCHED; PG8_LDA(At, 0, 0); PG8_STAGE(PG8_SA(1, 1), a1 + hstepA, voffA);
            PG8_WAIT_V(8); PG8_WAIT_L(0); PG8_BAR; PG8_MMA(0, 0, At, B0); PG8_MMA(0, 1, At, B1); PG8_BAR; PG8_SCHED;
            PG8_LDA(At, 0, 1); PG8_STAGE(PG8_SB(0, 0), b2, voffB); PG8_STAGE(PG8_SB(0, 1), b2 + hstepB, voffB); PG8_STAGE(PG8_SA(0, 0), a2, voffA);
            PG8_WAIT_V(8); PG8_WAIT_L(0); PG8_BAR; PG8_MMA(1, 0, At, B0); PG8_MMA(1, 1, At, B1); PG8_BAR; PG8_SCHED;
            PG8_LDB(B0, 1, 0); PG8_LDB(B1, 1, 1); PG8_SCHED; PG8_LDA(At, 1, 0); PG8_STAGE(PG8_SA(0, 1), a2 + hstepA, voffA);
            PG8_WAIT_V(8); PG8_WAIT_L(0); PG8_BAR; PG8_MMA(0, 0, At, B0); PG8_MMA(0, 1, At, B1); PG8_BAR; PG8_SCHED;
            PG8_LDA(At, 1, 1); PG8_STAGE(PG8_SB(1, 0), b3, voffB); PG8_STAGE(PG8_SB(1, 1), b3 + hstepB, voffB); PG8_STAGE(PG8_SA(1, 0), a3, voffA);
            PG8_WAIT_V(8); PG8_WAIT_L(0); PG8_BAR; PG8_MMA(1, 0, At, B0); PG8_MMA(1, 1, At, B1); PG8_BAR; PG8_SCHED;
            } else {
            PG8_LDB(B0, 0, 0); PG8_SCHED; PG8_LDA(At, 0, 0); PG8_STAGE(PG8_SA(1, 1), a1 + hstepA, voffA);
            PG8_WAIT_L(8); PG8_BAR; PG8_WAIT_L(0); PG8_MMA(0, 0, At, B0); PG8_BAR; PG8_SCHED;
            PG8_LDB(B1, 0, 1); PG8_STAGE(PG8_SB(0, 0), b2, voffB);
            PG8_BAR; PG8_WAIT_L(0); PG8_MMA(0, 1, At, B1); PG8_BAR;
            PG8_LDA(At, 0, 1); PG8_STAGE(PG8_SA(0, 0), a2, voffA);
            PG8_BAR; PG8_WAIT_L(0); PG8_MMA(1, 0, At, B0); PG8_BAR; PG8_SCHED;
            PG8_STAGE(PG8_SB(0, 1), b2 + hstepB, voffB);
            PG8_WAIT_V(6); PG8_BAR; PG8_MMA(1, 1, At, B1); PG8_BAR;
            PG8_LDB(B0, 1, 0); PG8_SCHED; PG8_LDA(At, 1, 0); PG8_STAGE(PG8_SA(0, 1), a2 + hstepA, voffA);
            PG8_WAIT_L(8); PG8_BAR; PG8_WAIT_L(0); PG8_MMA(0, 0, At, B0); PG8_BAR; PG8_SCHED;
            PG8_LDB(B1, 1, 1); PG8_STAGE(PG8_SB(1, 0), b3, voffB);
            PG8_BAR; PG8_WAIT_L(0); PG8_MMA(0, 1, At, B1); PG8_BAR;
            PG8_LDA(At, 1, 1); PG8_STAGE(PG8_SA(1, 0), a3, voffA);
            PG8_BAR; PG8_WAIT_L(0); PG8_MMA(1, 0, At, B0); PG8_BAR; PG8_SCHED;
            PG8_STAGE(PG8_SB(1, 1), b3 + hstepB, voffB);
            PG8_WAIT_V(6); PG8_BAR; PG8_MMA(1, 1, At, B1); PG8_BAR;
            }
        }
        if constexpr (ALIGN_EPI) { if (wr == 0) PG8_BAR; }
        if constexpr (!Epi::AFTER_DRAIN) { int fr_e = fr, fq_e = fq; asm volatile("" : "+v"(fr_e), "+v"(fq_e)); f32x4 raw_[8]; const Unit pu_ = has_next ? nxt : cur; if constexpr (Epi::PRE) E.pre_issue(pu_, wr, fr_e, fq_e, raw_); E(acc, cur, wr, wc, fr_e, fq_e, rs_); if constexpr (Epi::PRE) E.pre_finish(raw_, rs_); S.done(cur); }
        if (!has_next) break;
#pragma unroll
        for (int a = 0; a < 2; ++a)
#pragma unroll
            for (int b = 0; b < 2; ++b)
#pragma unroll
                for (int m = 0; m < 4; ++m)
#pragma unroll
                    for (int n = 0; n < 2; ++n) acc[a][b][m][n] = (f32x4){0.f, 0.f, 0.f, 0.f};
        cur = nxt; cA = nA; cB = nB; ++ui; ntc = S.ktn(cur, nt);
        if constexpr (ALIGN_EPI) { if (wr == 1) PG8_BAR; }
    }
    PG8_WAIT_V(0);
    if constexpr (!ALIGN_EPI) { if (wr == 0) PG8_BAR; }
    PG8_BAR;
    if constexpr (Epi::AFTER_DRAIN) { E.fused(acc, cur, wr, wc, fr, fq, lds, wid, lane); S.done(cur); }
#undef PG8_SA
#undef PG8_SB
#undef PG8_STAGE
#undef PG8_LDA
#undef PG8_LDB
#undef PG8_MMA
#undef PG8_WAIT_V
#undef PG8_WAIT_L
#undef PG8_BAR
#undef PG8_SCHED
}
}

using pg8::bf16_t; using pg8::bf16x8; using pg8::f32x4; using pg8::f32x16; using pg8::u32x4; using pg8::u32x2; using pg8::cvt_pk_bf16; using pg8::EPS;
#define LAS __attribute__((address_space(3)))
constexpr int NB = 16, SEQ = 4096, D = 1024, M = NB * SEQ, FF = 2816, NH = 8, NTHR = 512;
constexpr size_t MiB = 1u << 20;
constexpr size_t WS_SSH = 0, WS_SSQ = 4 * MiB, WS_SSKV = 5 * MiB, WS_SSV = 6 * MiB, WS_CS = 8 * MiB, WS_W = 16 * MiB;
constexpr size_t FFN_W_BYTES = 16 * MiB + 512 * 1024;
constexpr size_t WS_EVEN = WS_W + 8 * FFN_W_BYTES;
constexpr size_t WS_ODD = WS_EVEN + 12 * MiB;
constexpr size_t WS_HB = WS_ODD + 12 * MiB;
constexpr size_t WS_A = WS_HB + 128 * MiB;
constexpr size_t WS_B = WS_A + 352 * MiB;
constexpr size_t WS_MIX = WS_B + 224 * MiB;
constexpr size_t WS_END = WS_MIX + 128 * MiB;
constexpr int LDS_BYTES = 147456, LDS_TAB = 131072, LDS_MISC = 135168;
constexpr size_t WS_CTL = WS_EVEN + 3 * MiB + 512 * 1024, CTL_BYTES = 16384;
constexpr float C2Q = 0.10206207261596577f * 1.4426950408889634f;

struct Args { const float* in[22]; float* out; unsigned char* ws; };

__device__ __forceinline__ float bf2f(unsigned short b) { return __uint_as_float((unsigned)b << 16); }
__device__ __forceinline__ void unpack8(u32x4 w, float* v) {
#pragma unroll
    for (int i = 0; i < 4; ++i) { v[2 * i] = __uint_as_float(w[i] << 16); v[2 * i + 1] = __uint_as_float(w[i] & 0xffff0000u); }
}
__device__ __forceinline__ u32x4 pack8(const float* v) { u32x4 w; w.x = cvt_pk_bf16(v[0], v[1]); w.y = cvt_pk_bf16(v[2], v[3]); w.z = cvt_pk_bf16(v[4], v[5]); w.w = cvt_pk_bf16(v[6], v[7]); return w; }
#define LDS_WAIT() asm volatile("s_waitcnt lgkmcnt(0)" ::: "memory")
__device__ __forceinline__ int otid() { int t = threadIdx.x; asm volatile("" : "+v"(t)); return t; }
__device__ __forceinline__ unsigned char* oq(unsigned char* p) { asm volatile("" : "+s"(p)); return p; }
template <int KSLOT> __device__ __forceinline__ unsigned long long karg_u64() {
    const unsigned long long base = (unsigned long long)__builtin_amdgcn_kernarg_segment_ptr(); unsigned long long v;
    asm volatile("s_load_dwordx2 %0, %1, %2\n\ts_waitcnt lgkmcnt(0)" : "=s"(v) : "s"(base), "n"(KSLOT * 8) : "memory");
    return v;
}
#define GASQ __attribute__((address_space(1)))
#define KIN(k) ((const float*)(const GASQ float*)karg_u64<(k)>())
#define KOUT ((float*)(GASQ float*)karg_u64<22>())
#define KWS ((unsigned char*)(GASQ unsigned char*)karg_u64<23>())

__device__ __forceinline__ void tr_item(const float* W, int N, const float* gain, bf16_t* dst, int ldd, int koff, int mode, int row_off, int kb, int nb, LAS float* scr, int lane) {
    const int k0 = 64 * kb, n0 = 32 * nb;
#pragma unroll
    for (int i = 0; i < 8; ++i) { const int kk = 8 * i + (lane >> 3), c4 = 4 * (lane & 7); f32x4 v = __builtin_nontemporal_load((const f32x4*)(W + (size_t)(k0 + kk) * N + n0 + c4));     if (gain) v = v * gain[k0 + kk];
        scr[kk * 33 + c4] = v[0]; scr[kk * 33 + c4 + 1] = v[1]; scr[kk * 33 + c4 + 2] = v[2]; scr[kk * 33 + c4 + 3] = v[3]; }
    LDS_WAIT();
    const int c = lane & 7;
#pragma unroll
    for (int j = 0; j < 4; ++j) {
        const int n = (lane >> 3) + 8 * j, nn = n0 + n;
        const int row = (mode == 0) ? (row_off + nn) : (256 * (nn >> 7) + (nn & 127) + (mode == 2 ? 128 : 0));
        const LAS float* s = scr + (8 * c) * 33 + n;
        u32x4 o; o.x = cvt_pk_bf16(s[0 * 33], s[1 * 33]); o.y = cvt_pk_bf16(s[2 * 33], s[3 * 33]); o.z = cvt_pk_bf16(s[4 * 33], s[5 * 33]); o.w = cvt_pk_bf16(s[6 * 33], s[7 * 33]);
        *(u32x4*)(dst + (size_t)row * ldd + koff + k0 + 8 * c) = o;
    }
    LDS_WAIT();
}
constexpr int IT_MAT = 1408, IT_FFN = 3 * IT_MAT, IT_FFN_ALL = 8 * IT_FFN, IT_EVEN = 880, IT_ODD = 1536, IT_TOTAL = IT_FFN_ALL + 2 * IT_EVEN + 2 * IT_ODD;

__device__ __forceinline__ void prologue(LAS unsigned char* lds, int G) {
    const int tid = otid(), lane = tid & 63, wave = __builtin_amdgcn_readfirstlane(tid >> 6);
    unsigned char* ws = KWS;
    const int gw = blockIdx.x * 8 + wave, NGW = G * 8;
    const int gt = blockIdx.x * NTHR + tid, NGT = G * NTHR;
    LAS float* scr = (LAS float*)(lds + wave * 16384);
    for (int it0 = gw; it0 < IT_TOTAL; it0 += NGW) {
        int it = it0;
        if (it < IT_FFN_ALL) {
            const int f = it / IT_FFN, r = it % IT_FFN, mat = r / IT_MAT, q = r % IT_MAT;
            bf16_t* wgu = (bf16_t*)(ws + WS_W + (size_t)f * FFN_W_BYTES); bf16_t* wd = wgu + (size_t)5632 * 1024;
            if (mat == 0) tr_item(KIN(3) + (size_t)f * 1024 * FF, FF, KIN(2) + f * 1024, wgu, 1024, 0, 1, 0, q / 88, q % 88, scr, lane);
            else if (mat == 1) tr_item(KIN(4) + (size_t)f * 1024 * FF, FF, KIN(2) + f * 1024, wgu, 1024, 0, 2, 0, q / 88, q % 88, scr, lane);
            else tr_item(KIN(5) + (size_t)f * FF * 1024, 1024, nullptr, wd, FF, 0, 0, 0, q / 32, q % 32, scr, lane);
            continue;
        }
        it -= IT_FFN_ALL;
        if (it < 2 * IT_EVEN) {
            const int e = it / IT_EVEN; int r = it % IT_EVEN;
            bf16_t* win = (bf16_t*)(ws + WS_EVEN + (size_t)e * 6 * MiB); bf16_t* wqkv = win + 1024 * 1024; bf16_t* wout = (bf16_t*)(ws + WS_EVEN + (size_t)e * 6 * MiB + 4 * MiB);
            if (r < 464) { tr_item(KIN(7) + (size_t)e * 1024 * 928, 928, KIN(6) + (2 * e) * 1024, win, 1024, 0, 0, 0, r / 29, r % 29, scr, lane); continue; }
            r -= 464;
            if (r < 96) { tr_item(KIN(10) + (size_t)e * 256 * 768, 768, KIN(8) + e * 256, wqkv, 384, 0, 0, 0, r / 24, r % 24, scr, lane); continue; }
            r -= 96;
            if (r < 64) { tr_item(KIN(11) + (size_t)e * 128 * 1024, 1024, KIN(9) + e * 128, wqkv, 384, 256, 0, 768, r / 32, r % 32, scr, lane); continue; }
            r -= 64;
            tr_item(KIN(16) + (size_t)e * 1024 * 1024, 1024, nullptr, wout, 1024, 0, 0, 0, r / 32, r % 32, scr, lane);
            continue;
        }
        it -= 2 * IT_EVEN;
        {
            const int o = it / IT_ODD; int r = it % IT_ODD;
            bf16_t* wu = (bf16_t*)(ws + WS_ODD + (size_t)o * 6 * MiB); bf16_t* wv = wu + 1024 * 1024; bf16_t* wout = wv + 1024 * 1024;
            if (r < 1024) { const int kb = r / 64, nb = r % 64; tr_item(KIN(17) + (size_t)o * 1024 * 2048, 2048, KIN(6) + (2 * o + 1) * 1024, nb < 32 ? wu : wv, 1024, 0, 0, nb < 32 ? 0 : -1024, kb, nb, scr, lane); continue; }
            r -= 1024;
            tr_item(KIN(21) + (size_t)o * 1024 * 1024, 1024, nullptr, wout, 1024, 0, 0, 0, r / 32, r % 32, scr, lane);
        }
    }
    for (int i0 = gt; i0 < 2 * 57344; i0 += NGT) {
        const int e = i0 / 57344; int i = i0 % 57344;
        bf16_t* win = (bf16_t*)(ws + WS_EVEN + (size_t)e * 6 * MiB); bf16_t* wqkv = win + 1024 * 1024;
        const u32x4 z = {0u, 0u, 0u, 0u};
        if (i < 12288) { *(u32x4*)(wqkv + (size_t)(i / 16) * 384 + 256 + 8 * (i % 16)) = z; continue; }
        i -= 12288;
        if (i < 32768) { *(u32x4*)(wqkv + (size_t)(768 + i / 32) * 384 + 8 * (i % 32)) = z; continue; }
        i -= 32768;
        *(u32x4*)(win + (size_t)(928 + i / 128) * 1024 + 8 * (i % 128)) = z;
    }
    for (int i0 = gw; i0 < 2 * 2048; i0 += NGW) {
        const int e = i0 / 2048, r = i0 % 2048, kq = r / 16, nblk = r % 16, kp = 4 * kq, g = kp >> 7, c = kp & 127, n = nblk * 64 + lane;
        const float* pw = KIN(14) + ((size_t)(e * 4 + g) * 128 + c) * 128;
        const float* sc = KIN(15) + e * 512 + g * 128;
        const float* wo = KIN(16) + (size_t)e * 1024 * 1024 + (size_t)(512 + g * 128) * 1024 + n;
        float acc[4] = {0.f, 0.f, 0.f, 0.f};
#pragma unroll 1
        for (int d0 = 0; d0 < 128; d0 += 32) {
            float wv[32];
#pragma unroll
            for (int d = 0; d < 32; ++d) wv[d] = wo[(size_t)(d0 + d) * 1024];
#pragma unroll
            for (int d = 0; d < 32; ++d) { const float w = wv[d] * sc[d0 + d];
#pragma unroll
                for (int k = 0; k < 4; ++k) acc[k] += pw[k * 128 + d0 + d] * w; }
        }
        bf16_t* wout = (bf16_t*)(ws + WS_EVEN + (size_t)e * 6 * MiB + 4 * MiB);
        u32x2 w; w.x = cvt_pk_bf16(acc[0], acc[1]); w.y = cvt_pk_bf16(acc[2], acc[3]);
        *(u32x2*)(wout + (size_t)n * 1024 + 512 + kp) = w;
    }
    {
        const int* pos = (const int*)KIN(1); float* cs = (float*)(ws + WS_CS);
        for (int i0 = gt; i0 < M * 16; i0 += NGT) {
            const int tok = i0 >> 4, i = i0 & 15;
            const float inv = (float)exp2(-(double)i * (13.287712379549449 / 16.0));
            const float ang = (float)pos[tok] * inv;
            const double rev = (double)ang * 0.15915494309189535; const float fr = (float)(rev - rint(rev));
            cs[(size_t)tok * 32 + i] = __builtin_amdgcn_cosf(fr); cs[(size_t)tok * 32 + 16 + i] = __builtin_amdgcn_sinf(fr);
        }
    }
    {
        bf16_t* hb = (bf16_t*)(ws + WS_HB); float* ssh = (float*)(ws + WS_SSH);
        const float* x0 = KIN(0);
        for (int m0 = gw; m0 < M; m0 += 4 * NGW) {
            f32x4 v[4][4]; float sq[4];
#pragma unroll
            for (int r = 0; r < 4; ++r) { const int m = m0 + r * NGW; const f32x4* xr = (const f32x4*)(x0 + (size_t)(m < M ? m : m0) * D) + lane;
#pragma unroll
                for (int j = 0; j < 4; ++j) v[r][j] = __builtin_nontemporal_load(xr + 64 * j); }
#pragma unroll
            for (int r = 0; r < 4; ++r) { const int m = m0 + r * NGW; if (m < M) { u32x2* o8 = (u32x2*)(hb + (size_t)m * D) + lane; float s = 0.f;
#pragma unroll
                for (int j = 0; j < 4; ++j) { s += pg8::dot4(v[r][j]); u32x2 w; w.x = cvt_pk_bf16(v[r][j][0], v[r][j][1]); w.y = cvt_pk_bf16(v[r][j][2], v[r][j][3]); o8[64 * j] = w; }
                sq[r] = s; } else sq[r] = 0.f; }
#pragma unroll
            for (int r = 0; r < 4; ++r) { float s = sq[r];
#pragma unroll
                for (int o = 1; o < 64; o <<= 1) s += __shfl_xor(s, o);
                const int m = m0 + r * NGW; if (m < M && lane < 16) ssh[(size_t)m * 16 + lane] = (lane == 0) ? s : 0.f; }
        }
    }
}

template <int W> __device__ __forceinline__ void pool_item(const bf16_t* p, int s, bf16_t* dst) {
    float acc[8], cur[8];
    u32x4 raw[W];
#pragma unroll
    for (int j = 0; j < W; ++j) { const int jj = j <= s ? j : s; raw[j] = *(const u32x4*)(p - (size_t)jj * 1024); }
    unpack8(raw[0], cur);
#pragma unroll
    for (int i = 0; i < 8; ++i) acc[i] = cur[i];
#pragma unroll
    for (int j = 1; j < W; ++j) { float v[8]; unpack8(raw[j], v); const float ok = j <= s ? 1.0f : 0.0f;
#pragma unroll
        for (int i = 0; i < 8; ++i) acc[i] += ok * v[i]; }
    const int cnt = (s + 1 < W) ? (s + 1) : W; const float ic = 1.0f / (float)cnt;
#pragma unroll
    for (int i = 0; i < 8; ++i) acc[i] = acc[i] * ic - cur[i];
    *(u32x4*)dst = pack8(acc);
}
__device__ __forceinline__ void pool_phase(const bf16_t* proj, bf16_t* mix, int G) {
    const int tid = otid(), lane = tid & 63, wid = __builtin_amdgcn_readfirstlane(tid >> 6);
    const int g = wid & 3, tq = wid >> 2, cc = g * 16 + (lane & 15);
    for (int item = blockIdx.x; item < M / 8; item += G) {
        const int tok = item * 8 + tq * 4 + (lane >> 4), s = tok & (SEQ - 1);
        const bf16_t* p = proj + (size_t)tok * 1024 + 416 + cc * 8; bf16_t* dst = mix + (size_t)tok * 1024 + 512 + cc * 8;
        if (g == 0) pool_item<2>(p, s, dst); else if (g == 1) pool_item<4>(p, s, dst); else if (g == 2) pool_item<8>(p, s, dst); else pool_item<16>(p, s, dst);
    }
}

__device__ __forceinline__ void kpost_phase(const bf16_t* qkv, const bf16_t* proj, const float* cstab, const float* kg, bf16_t* KF, int G) {
    const int tid = otid(), sub = tid & 3;
    for (int idx = (blockIdx.x * NTHR + tid) >> 2; idx < M * NH; idx += (G * NTHR) >> 2) {
        const int tok = idx >> 3, h = idx & 7, b = tok / SEQ, s = tok & (SEQ - 1);
        const bf16_t* s0 = qkv + (size_t)tok * 1792 + 768 + h * 128 + 8 * sub; const bf16_t* s1 = proj + (size_t)tok * 1024 + 384 + 8 * sub;
        const float* cs = cstab + (size_t)tok * 32;
        bf16_t* dst = KF + ((size_t)(b * NH + h) * SEQ + s) * 96 + 8 * sub;
        const u32x4 r0 = *(const u32x4*)s0, r1 = *(const u32x4*)(s0 + 32), r2 = *(const u32x4*)s1;
        float v0[8], v1[8], v2[8]; unpack8(r0, v0); unpack8(r1, v1); unpack8(r2, v2);
        float ss = 0.f;
#pragma unroll
        for (int i = 0; i < 8; ++i) ss += v0[i] * v0[i] + v1[i] * v1[i] + v2[i] * v2[i];
        ss += pg8::sxor<1>(ss); ss += pg8::sxor<2>(ss);
        const float rs = __builtin_amdgcn_rsqf(ss * (1.0f / 96.0f) + EPS);
#pragma unroll
        for (int i = 0; i < 8; ++i) { v0[i] = v0[i] * rs * kg[8 * sub + i]; v1[i] = v1[i] * rs * kg[32 + 8 * sub + i]; v2[i] = v2[i] * rs * kg[64 + 8 * sub + i]; }
        *(u32x4*)dst = pack8(v0); *(u32x4*)(dst + 32) = pack8(v1);
        float o[8];
#pragma unroll
        for (int i = 0; i < 8; ++i) { const float other = pg8::sxor<2>(v2[i]); const int j = 8 * (sub & 1) + i; const float co = cs[j], si = cs[16 + j];
            o[i] = (sub < 2) ? (v2[i] * co - other * si) : (other * si + v2[i] * co); }
        *(u32x4*)(dst + 64) = pack8(o);
    }
}

namespace att {
constexpr int KROW = 208, VROW = 192, KBUF = 64 * KROW, VBUF = 64 * VROW, BUFB = KBUF + VBUF;
typedef short v4i16_t __attribute__((ext_vector_type(4)));
#define MFMA32(a, b, c) __builtin_amdgcn_mfma_f32_32x32x16_bf16(a, b, c, 0, 0, 0)
__device__ __forceinline__ void attn_unit(int bh, int qb, const bf16_t* QKV, const bf16_t* KF, const float* cstab, const float* qg, bf16_t* MIX, LAS unsigned char* lds) {
    const int tid = otid(), lane = tid & 63, r32 = lane & 31, hi = lane >> 5, wid = __builtin_amdgcn_readfirstlane(tid >> 6);
    const int b = bh >> 3, h = bh & 7, q0 = qb * 256, qw = q0 + 32 * wid, q = qw + r32;
    bf16x8 qf[6];
    {
        const bf16_t* Qp = QKV + (size_t)(b * SEQ + q) * 1792 + h * 96 + 8 * hi;
        const float* cs = cstab + (size_t)(b * SEQ + q) * 32 + 8 * hi;
        u32x4 raw[6];
#pragma unroll
        for (int d0 = 0; d0 < 6; ++d0) raw[d0] = *(const u32x4*)(Qp + 16 * d0);
        float ss = 0.f;
#pragma unroll
        for (int d0 = 0; d0 < 6; ++d0) { float v[8]; unpack8(raw[d0], v);
#pragma unroll
            for (int i = 0; i < 8; ++i) ss += v[i] * v[i]; }
        ss = pg8::sum32(ss);
        const float rs = __builtin_amdgcn_rsqf(ss * (1.0f / 96.0f) + EPS) * C2Q;
#pragma unroll
        for (int d0 = 0; d0 < 4; ++d0) { float v[8]; unpack8(raw[d0], v);
#pragma unroll
            for (int i = 0; i < 8; ++i) v[i] = v[i] * rs * qg[16 * d0 + 8 * hi + i];
            qf[d0] = __builtin_bit_cast(bf16x8, pack8(v)); }
        float x1[8], x2[8], o1[8], o2[8]; unpack8(raw[4], x1); unpack8(raw[5], x2);
#pragma unroll
        for (int i = 0; i < 8; ++i) { const float y1 = x1[i] * rs * qg[64 + 8 * hi + i], y2 = x2[i] * rs * qg[80 + 8 * hi + i], co = cs[i], si = cs[16 + i];
            o1[i] = y1 * co - y2 * si; o2[i] = y1 * si + y2 * co; }
        qf[4] = __builtin_bit_cast(bf16x8, pack8(o1)); qf[5] = __builtin_bit_cast(bf16x8, pack8(o2));
    }
    const char* Kg = (const char*)(KF + (size_t)bh * SEQ * 96);
    const char* Vg = (const char*)(QKV + (size_t)b * SEQ * 1792 + 768 + h * 128 + 64) + (size_t)(tid >> 3) * 3584 + (tid & 7) * 16;
    const int kofs0 = (tid / 12) * KROW + (tid % 12) * 16, kofs1 = ((tid + 512) / 12) * KROW + ((tid + 512) % 12) * 16, vofs = KBUF + (tid >> 3) * VROW + (tid & 7) * 16;
    const int vtb = KBUF + (4 * hi + ((lane & 15) >> 2)) * VROW + (16 * ((lane >> 4) & 1) + 4 * (lane & 3)) * 2;
    const int NT = 4 * (qb + 1);
    u32x4 kr0, kr1 = {0u, 0u, 0u, 0u}, vr;
#define ATT_LOAD(t) do { kr0 = *(const u32x4*)(Kg + (size_t)(t) * 12288 + tid * 16); if (tid < 256) kr1 = *(const u32x4*)(Kg + (size_t)(t) * 12288 + (tid + 512) * 16); vr = *(const u32x4*)(Vg + (size_t)(t) * (64 * 3584)); } while (0)
#define ATT_WRITE(bufp) do { *(LAS u32x4*)((bufp) + kofs0) = kr0; if (tid < 256) *(LAS u32x4*)((bufp) + kofs1) = kr1; *(LAS u32x4*)((bufp) + vofs) = vr; } while (0)
    float mrun = 0.f, lrun = 0.f;
    f32x16 o0, o1, negm;
#pragma unroll
    for (int r = 0; r < 16; ++r) { o0[r] = 0.f; o1[r] = 0.f; negm[r] = 0.f; }
    ATT_LOAD(0); ATT_WRITE(lds);
    __syncthreads();
    for (int t = 0; t < NT; ++t) {
        LAS unsigned char* buf = lds + (t & 1) * BUFB;
        if (t + 1 < NT) ATT_LOAD(t + 1);
#pragma unroll
        for (int kb = 0; kb < 2; ++kb) {
            const int key0 = 64 * t + 32 * kb;
            if (key0 > qw + 31) continue;
            const LAS unsigned char* kp = buf + (32 * kb + r32) * KROW + 16 * hi;
            f32x16 p = negm;
            bf16x8 kfr[6];
#pragma unroll
            for (int d0 = 0; d0 < 6; ++d0) kfr[d0] = *(const LAS bf16x8*)(kp + 32 * d0);
            __builtin_amdgcn_s_setprio(1);
#pragma unroll
            for (int d0 = 0; d0 < 6; ++d0) p = MFMA32(kfr[d0], qf[d0], p);
            __builtin_amdgcn_s_setprio(0);
            if (key0 + 31 > qw) {
#pragma unroll
                for (int r = 0; r < 16; ++r) { const int key = key0 + (r & 3) + 8 * (r >> 2) + 4 * hi; if (key > q) p[r] = -1e30f; }
            }
            float mx = fmaxf(fmaxf(p[0], p[1]), fmaxf(p[2], p[3]));
#pragma unroll
            for (int r = 4; r < 16; r += 4) mx = fmaxf(mx, fmaxf(fmaxf(p[r], p[r + 1]), fmaxf(p[r + 2], p[r + 3])));
            mx = pg8::max32(mx);
            if (key0 == 0 || __any(mx > 4.0f)) {
                const float dl = (key0 == 0) ? mx : fmaxf(mx, 0.f), f = __builtin_amdgcn_exp2f(-dl);
                mrun += dl; lrun *= f;
#pragma unroll
                for (int r = 0; r < 16; ++r) { o0[r] *= f; o1[r] *= f; p[r] -= dl; negm[r] = -mrun; }
            }
            float ps = 0.f;
#pragma unroll
            for (int r = 0; r < 16; ++r) { p[r] = __builtin_amdgcn_exp2f(p[r]); ps += p[r]; }
            lrun += ps;
            u32x4 w0, w1;
#pragma unroll
            for (int k = 0; k < 4; ++k) { w0[k] = cvt_pk_bf16(p[2 * k], p[2 * k + 1]); w1[k] = cvt_pk_bf16(p[8 + 2 * k], p[8 + 2 * k + 1]); }
            const bf16x8 pb0 = __builtin_bit_cast(bf16x8, w0), pb1 = __builtin_bit_cast(bf16x8, w1);
            const LAS unsigned char* vp = buf + vtb + (32 * kb) * VROW;
#pragma unroll
            for (int db = 0; db < 2; ++db) {
                const v4i16_t a0 = __builtin_amdgcn_ds_read_tr16_b64_v4i16((LAS v4i16_t*)(vp + db * 64));
                const v4i16_t a1 = __builtin_amdgcn_ds_read_tr16_b64_v4i16((LAS v4i16_t*)(vp + db * 64 + 8 * VROW));
                const v4i16_t c0 = __builtin_amdgcn_ds_read_tr16_b64_v4i16((LAS v4i16_t*)(vp + db * 64 + 16 * VROW));
                const v4i16_t c1 = __builtin_amdgcn_ds_read_tr16_b64_v4i16((LAS v4i16_t*)(vp + db * 64 + 24 * VROW));
                const bf16x8 va = {a0[0], a0[1], a0[2], a0[3], a1[0], a1[1], a1[2], a1[3]}, vc = {c0[0], c0[1], c0[2], c0[3], c1[0], c1[1], c1[2], c1[3]};
                __builtin_amdgcn_s_setprio(1);
                if (db == 0) { o0 = MFMA32(va, pb0, o0); o0 = MFMA32(vc, pb1, o0); }
                else { o1 = MFMA32(va, pb0, o1); o1 = MFMA32(vc, pb1, o1); }
                __builtin_amdgcn_s_setprio(0);
            }
        }
        if (t + 1 < NT) { LAS unsigned char* nb = lds + ((t + 1) & 1) * BUFB; ATT_WRITE(nb); }
        __syncthreads();
    }
    const float l = pg8::sum32(lrun), inv = 1.0f / l;
    {
        constexpr int OROW = 144;
        LAS unsigned char* stg = lds + 2 * BUFB + wid * (32 * OROW);
#pragma unroll
        for (int rg = 0; rg < 4; ++rg) {
            u32x2 w; w.x = cvt_pk_bf16(o0[4 * rg] * inv, o0[4 * rg + 1] * inv); w.y = cvt_pk_bf16(o0[4 * rg + 2] * inv, o0[4 * rg + 3] * inv);
            u32x2 x; x.x = cvt_pk_bf16(o1[4 * rg] * inv, o1[4 * rg + 1] * inv); x.y = cvt_pk_bf16(o1[4 * rg + 2] * inv, o1[4 * rg + 3] * inv);
            *(LAS u32x2*)(stg + r32 * OROW + (8 * rg + 4 * hi) * 2) = w; *(LAS u32x2*)(stg + r32 * OROW + (32 + 8 * rg + 4 * hi) * 2) = x;
        }
        asm volatile("s_waitcnt lgkmcnt(0)" ::: "memory");
        bf16_t* dst = MIX + ((size_t)(b * SEQ + qw)) * 1024 + h * 64 + (lane & 7) * 8;
#pragma unroll
        for (int it = 0; it < 4; ++it) { const int row = it * 8 + (lane >> 3); const u32x4 v = *(const LAS u32x4*)(stg + row * OROW + (lane & 7) * 16); *(u32x4*)(dst + (size_t)row * 1024) = v; }
    }
#undef ATT_LOAD
#undef ATT_WRITE
}
__device__ __forceinline__ void attn_phase(const bf16_t* QKV, const bf16_t* KF, const float* cstab, const float* qg, bf16_t* MIX, LAS unsigned char* lds, int G) {
    const int bx = blockIdx.x, vcu = (G % 8 == 0) ? (bx % 8) * (G / 8) + bx / 8 : bx;
    for (int P = vcu; P < 1024; P += G) {
        const int bh = P >> 3, j = P & 7;
        attn_unit(bh, 15 - j, QKV, KF, cstab, qg, MIX, lds);
        attn_unit(bh, j, QKV, KF, cstab, qg, MIX, lds);
    }
}
}

__device__ __forceinline__ void sg_phase(const float* sgw, const float* sgb, const float* sgn, const bf16_t* U, const bf16_t* VTc, const float* ssv, bf16_t* GATED, LAS unsigned char* lds, int G) {
    const int tid = otid(), lane = tid & 63, fr = lane & 15, fq = lane >> 4, wid = __builtin_amdgcn_readfirstlane(tid >> 6);
    constexpr int WROW = 272, TAB_OFF = 36864;
    LAS float* tab = (LAS float*)(lds + TAB_OFF);
    for (int unit = blockIdx.x; unit < 2048; unit += G) {
        const int chunk = unit >> 2, g = unit & 3, tok0 = chunk * 128;
        bf16x8 bfr[2][4];
        const bf16_t* vb = VTc + ((size_t)chunk * 1024 + g * 256 + 32 * wid + 8 * (fr >> 2) + (fr & 3)) * 128 + 8 * fq;
#pragma unroll
        for (int nf = 0; nf < 2; ++nf)
#pragma unroll
            for (int kk = 0; kk < 4; ++kk) bfr[nf][kk] = *(const bf16x8*)(vb + (size_t)nf * 4 * 128 + 32 * kk);
        u32x4 uu[8];
        const size_t rowoff = (size_t)(tok0 + fr) * 1024 + g * 256 + 32 * wid + 8 * fq;
#pragma unroll
        for (int tf = 0; tf < 8; ++tf) uu[tf] = *(const u32x4*)(U + rowoff + (size_t)tf * 16 * 1024);
        if (tid < 128) { const f32x4* p = (const f32x4*)(ssv + (size_t)(tok0 + tid) * 8); tab[tid] = __builtin_amdgcn_rsqf((pg8::hsum4(p[0]) + pg8::hsum4(p[1])) * (1.0f / 1024.0f) + EPS); }
        __syncthreads();
        {
            const int t = tid >> 2, sg0 = 32 * (tid & 3);
            if (sg0 <= t) {
                const float* wrow = sgw + ((size_t)g * 128 + t) * 128 + sg0;
#pragma unroll
                for (int c = 0; c < 4; ++c) { const f32x4 wa = *(const f32x4*)(wrow + 8 * c), wb = *(const f32x4*)(wrow + 8 * c + 4); float av[8];
#pragma unroll
                    for (int j = 0; j < 8; ++j) { const int s = sg0 + 8 * c + j; const float w = j < 4 ? wa[j] : wb[j - 4]; av[j] = (s <= t) ? w * tab[s] : 0.f; }
                    *(LAS u32x4*)(lds + t * WROW + (sg0 + 8 * c) * 2) = pack8(av); }
            }
        }
        __syncthreads();
        f32x4 acc[8][2];
#pragma unroll
        for (int tf = 0; tf < 8; ++tf) { acc[tf][0] = (f32x4){0.f, 0.f, 0.f, 0.f}; acc[tf][1] = (f32x4){0.f, 0.f, 0.f, 0.f}; }
#pragma unroll
        for (int tf = 0; tf < 8; ++tf)
#pragma unroll
            for (int kk = 0; kk < 4; ++kk) if (kk <= (tf >> 1)) {
                const bf16x8 af = *(const LAS bf16x8*)(lds + (16 * tf + fr) * WROW + (32 * kk + 8 * fq) * 2);
                acc[tf][0] = __builtin_amdgcn_mfma_f32_16x16x32_bf16(bfr[0][kk], af, acc[tf][0], 0, 0, 0);
                acc[tf][1] = __builtin_amdgcn_mfma_f32_16x16x32_bf16(bfr[1][kk], af, acc[tf][1], 0, 0, 0);
            }
        const f32x4 gn0 = *(const f32x4*)(sgn + g * 256 + 32 * wid + 8 * fq), gn1 = *(const f32x4*)(sgn + g * 256 + 32 * wid + 8 * fq + 4);
#pragma unroll
        for (int tf = 0; tf < 8; ++tf) {
            const float bias = sgb[g * 128 + 16 * tf + fr];
            float uv[8], ov[8]; unpack8(uu[tf], uv);
#pragma unroll
            for (int i = 0; i < 4; ++i) { ov[i] = uv[i] * (acc[tf][0][i] * gn0[i] + bias); ov[4 + i] = uv[4 + i] * (acc[tf][1][i] * gn1[i] + bias); }
            *(u32x4*)(GATED + rowoff + (size_t)tf * 16 * 1024) = pack8(ov);
        }
        __syncthreads();
    }
}

#define XB_TMO      128
#define XB_XCNT(j)  (256  + 64 * (j))
#define XB_XSUB(j)  (1280 + 64 * (j))
#define XB_XGEN(j)  (2304 + 64 * (j))
#define XB_TOP      3328
#define XB_TOPGEN   3392
#define XCD_BAR_WORDS 3456
#define XB_SPIN_CAP (1u << 18)

__device__ __forceinline__ unsigned xb_ld(unsigned* p)              { return __hip_atomic_load(p, __ATOMIC_RELAXED, __HIP_MEMORY_SCOPE_AGENT); }
__device__ __forceinline__ unsigned xb_add(unsigned* p, unsigned v) { return __hip_atomic_fetch_add(p, v, __ATOMIC_RELAXED, __HIP_MEMORY_SCOPE_AGENT); }
__device__ __forceinline__ unsigned xb_xcc_id() { return (unsigned)__builtin_amdgcn_s_getreg((3 << 11) | 20) & 0xFu; }
#define XB_SPIN(cond, bar) do { unsigned _sp = 0; while (cond) { __builtin_amdgcn_s_sleep(1); \
    if ((++_sp & 255u) == 0u) { if (xb_ld(&(bar)[XB_TMO])) break; if (_sp > XB_SPIN_CAP) { atomicAdd(&(bar)[XB_TMO], 1u); break; } } } } while (0)

struct XcdBarrier {
    unsigned* bar; unsigned x;
    volatile LAS unsigned* st;
};

__device__ __forceinline__ XcdBarrier xcd_barrier_post(unsigned* bar, volatile LAS unsigned* st) {
    XcdBarrier b; b.bar = bar; b.x = xb_xcc_id(); b.st = st;
    if (threadIdx.x == 0) (void)xb_add(&bar[XB_XCNT(b.x)], 1u);
    return b;
}
__device__ __forceinline__ void xcd_barrier_complete(unsigned* bar, unsigned x, unsigned& nloc, unsigned& nx) {
    const unsigned G = gridDim.x * gridDim.y * gridDim.z;
    unsigned sum, cnt, mine, sp = 0u;
    for (;;) {
        sum = 0u; cnt = 0u; mine = 0u;
#pragma unroll
        for (unsigned j = 0; j < 16; ++j) { const unsigned c = xb_ld(&bar[XB_XCNT(j)]); sum += c; cnt += (c > 0u) ? 1u : 0u; mine = (j == x) ? c : mine; }
        if (sum == G) break;
        __builtin_amdgcn_s_sleep(1);
        if ((++sp & 255u) == 0u) { if (xb_ld(&bar[XB_TMO])) break; if (sp > XB_SPIN_CAP) { atomicAdd(&bar[XB_TMO], 1u); break; } }
    }
    nloc = mine > 0u ? mine : 1u; nx = cnt > 0u ? cnt : 1u;
}

__device__ __forceinline__ void xcd_barrier(const XcdBarrier& b) {
    asm volatile("s_waitcnt vmcnt(0)" ::: "memory");
    __syncthreads();
    if (threadIdx.x == 0) {
        unsigned* bar = b.bar;
        __builtin_amdgcn_s_waitcnt(0);
        unsigned nloc = b.st[0], nx = b.st[1];
        if (nloc == 0u) { xcd_barrier_complete(bar, b.x, nloc, nx); b.st[0] = nloc; b.st[1] = nx; }
        const unsigned old = xb_add(&bar[XB_XSUB(b.x)], 1u);
        const unsigned gen = old / nloc;
        if (old + 1u == (gen + 1u) * nloc) {
            __builtin_amdgcn_fence(__ATOMIC_RELEASE, "agent");
            asm volatile("s_waitcnt vmcnt(0)" ::: "memory");
            const unsigned og = xb_add(&bar[XB_TOP], 1u);
            const unsigned tg = og / nx;
            if (og + 1u == (tg + 1u) * nx) xb_add(&bar[XB_TOPGEN], 1u);
            else XB_SPIN(xb_ld(&bar[XB_TOPGEN]) == tg, bar);
            __builtin_amdgcn_fence(__ATOMIC_ACQUIRE, "agent");
            xb_add(&bar[XB_XGEN(b.x)], 1u);
            asm volatile("s_waitcnt vmcnt(0)" ::: "memory");
        } else {
            XB_SPIN(xb_ld(&bar[XB_XGEN(b.x)]) == gen, bar);
            __builtin_amdgcn_fence(__ATOMIC_ACQUIRE, "agent");
            asm volatile("s_waitcnt vmcnt(0)" ::: "memory");
        }
    }
    __syncthreads();
}

__global__ void __launch_bounds__(NTHR, 2) fwd_kernel(Args a) {
    extern __shared__ __attribute__((aligned(16))) unsigned char lds_raw[];
    cg::grid_group grid = cg::this_grid();
    LAS unsigned char* lds = (LAS unsigned char*)lds_raw;
    const int G = gridDim.x;
    if (threadIdx.x < 4) ((LAS unsigned*)(lds + LDS_MISC))[threadIdx.x] = 0u;
    __syncthreads();
    (void)xcd_barrier_post((unsigned*)(KWS + WS_CTL), (volatile LAS unsigned*)(lds + LDS_MISC));
#define XBAR() do { XcdBarrier xb_; xb_.bar = (unsigned*)(KWS + WS_CTL); xb_.x = xb_xcc_id(); xb_.st = (volatile LAS unsigned*)(lds + LDS_MISC); xcd_barrier(xb_); } while (0)

#ifndef PH_MASK
#define PH_MASK 0xFFFF
#endif
#ifndef RPT_MASK
#define RPT_MASK 0
#endif
#define RPT(x) (((PH_MASK & (x)) ? 1 : 0) + ((RPT_MASK & (x)) ? 1 : 0))
#define REPEAT(x) _Pragma("unroll 1") for (int rp_ = 0; rp_ < RPT(x); ++rp_)
    REPEAT(1) prologue(lds, G);
    grid.sync();

#pragma unroll 1
    for (int L = 0; L < 4; ++L) {
#pragma unroll 1
        for (int st = 0; st < 3; ++st) {
            unsigned char* ws = KWS; float* out = KOUT;
            float* ssh = (float*)(ws + WS_SSH); float* ssq = (float*)(ws + WS_SSQ); float* sskv = (float*)(ws + WS_SSKV); float* ssv = (float*)(ws + WS_SSV);
            const float* cstab = (const float*)(ws + WS_CS);
            bf16_t* HB = (bf16_t*)(ws + WS_HB);
            bf16_t* HID = (bf16_t*)(ws + WS_A); bf16_t* PROJ = (bf16_t*)(ws + WS_A); bf16_t* KF = (bf16_t*)(ws + WS_A + 224 * MiB);
            bf16_t* UU = (bf16_t*)(ws + WS_A); bf16_t* VTC = (bf16_t*)(ws + WS_A + 128 * MiB);
            bf16_t* QKV = (bf16_t*)(ws + WS_B); bf16_t* GATED = (bf16_t*)(ws + WS_B);
            bf16_t* MIX = (bf16_t*)(ws + WS_MIX);
            if (st != 1) {
                const int f = 2 * L + (st >> 1);
                const bf16_t* wgu = (const bf16_t*)(ws + WS_W + (size_t)f * FFN_W_BYTES); const bf16_t* wd = wgu + (size_t)5632 * 1024;
                {
                    pg8::Gemm g{HB, wgu, M, 5632, 1024, 1024, 1024}; pg8::StaticOrder S; S.init(M, 5632, G, (int)blockIdx.x);
                    pg8::EpiSwiGLU E{HID, ssh, FF};
                    REPEAT(2) pg8::gemm_phase<pg8::EpiSwiGLU, pg8::StaticOrder, true, true>(lds, g, S, E);
                }
                XBAR();
                {
                    pg8::Gemm g{HID, wd, M, 1024, FF, FF, FF}; pg8::StaticOrder S; S.init(M, 1024, G, (int)blockIdx.x);
                    pg8::EpiResid E{nullptr, (L == 3 && st == 2) ? out : nullptr, HB, ssh, 0.5f};
                    REPEAT(4) { pg8::EpiResid E2 = E; if (rp_ + 1 < RPT(4) && !E.xf) E2.alpha = 0.f; pg8::gemm_phase<pg8::EpiResid, pg8::StaticOrder, true, true>(lds, g, S, E2); }
                }
                XBAR();
            } else if ((L & 1) == 0) {
                const int e = L >> 1;
                const bf16_t* win = (const bf16_t*)(ws + WS_EVEN + (size_t)e * 6 * MiB); const bf16_t* wqkv = win + 1024 * 1024; const bf16_t* wout = (const bf16_t*)(ws + WS_EVEN + (size_t)e * 6 * MiB + 4 * MiB);
                {
                    pg8::Gemm g{HB, win, M, 1024, 1024, 1024, 1024}; pg8::StaticOrder S; S.init(M, 1024, G, (int)blockIdx.x);
                    pg8::EpiRowBf16<2> E{PROJ, 1024, ssh, ssq, sskv};
                    REPEAT(8) pg8::gemm_phase<pg8::EpiRowBf16<2>, pg8::StaticOrder, true, true>(lds, g, S, E);
                }
                XBAR();
                {
                    pg8::Gemm g{PROJ, wqkv, M, 1792, 384, 1024, 384}; pg8::QkvOrder S; S.init(M, 1792, G, (int)blockIdx.x);
                    pg8::EpiQKV E{QKV, 1792, ssq, sskv};
                    REPEAT(16) pg8::gemm_phase<pg8::EpiQKV, pg8::QkvOrder, true, true>(lds, g, S, E);
                    REPEAT(32) pool_phase(PROJ, MIX, G);
                }
                XBAR();
                REPEAT(64) kpost_phase(QKV, PROJ, cstab, KIN(13) + e * 96, KF, G);
                XBAR();
                REPEAT(128) att::attn_phase(QKV, KF, cstab, KIN(12) + e * 96, MIX, lds, G);
                XBAR();
                {
                    pg8::Gemm g{MIX, wout, M, 1024, 1024, 1024, 1024}; pg8::StaticOrder S; S.init(M, 1024, G, (int)blockIdx.x);
                    pg8::EpiResid E{nullptr, nullptr, HB, ssh, 1.0f};
                    REPEAT(2048) { pg8::EpiResid E2 = E; if (rp_ + 1 < RPT(2048)) E2.alpha = 0.f; pg8::gemm_phase<pg8::EpiResid, pg8::StaticOrder, true, true>(lds, g, S, E2); }
                }
                XBAR();
            } else {
                const int o = L >> 1;
                const bf16_t* wu = (const bf16_t*)(ws + WS_ODD + (size_t)o * 6 * MiB); const bf16_t* wv = wu + 1024 * 1024; const bf16_t* wout = wv + 1024 * 1024;
                {
                    pg8::Gemm g{HB, wu, M, 1024, 1024, 1024, 1024}; pg8::StaticOrder S; S.init(M, 1024, G, (int)blockIdx.x);
                    pg8::EpiRowBf16<1> E{UU, 1024, ssh, nullptr, nullptr};
                    REPEAT(256) pg8::gemm_phase<pg8::EpiRowBf16<1>, pg8::StaticOrder, true, true>(lds, g, S, E);
                }
                {
                    pg8::Gemm g{wv, HB, 1024, M, 1024, 1024, 1024}; pg8::StaticOrder S; S.init(1024, M, G, (int)blockIdx.x);
                    pg8::EpiVt E{VTC, ssh, ssv};
                    REPEAT(512) pg8::gemm_phase<pg8::EpiVt, pg8::StaticOrder, true, true>(lds, g, S, E);
                }
                XBAR();
                REPEAT(1024) sg_phase(KIN(19) + (size_t)o * 4 * 128 * 128, KIN(20) + o * 4 * 128, KIN(18) + o * 1024, UU, VTC, ssv, GATED, lds, G);
                XBAR();
                {
                    pg8::Gemm g{GATED, wout, M, 1024, 1024, 1024, 1024}; pg8::StaticOrder S; S.init(M, 1024, G, (int)blockIdx.x);
                    pg8::EpiResid E{nullptr, nullptr, HB, ssh, 1.0f};
                    REPEAT(2048) { pg8::EpiResid E2 = E; if (rp_ + 1 < RPT(2048)) E2.alpha = 0.f; pg8::gemm_phase<pg8::EpiResid, pg8::StaticOrder, true, true>(lds, g, S, E2); }
                }
                XBAR();
            }
        }
    }
}

extern "C" void kernel_launch(void* const* d_in, const int* in_sizes, int n_in, void* d_out, int out_size, void* d_ws, size_t ws_size, hipStream_t stream) {
    static int grid = 0;
    if (grid == 0) {
        if (n_in != 22 || out_size != M * D || ws_size < WS_END) { fprintf(stderr, "kernel_launch: unexpected shapes (n_in %d out %d ws %zu)\n", n_in, out_size, ws_size); grid = -1; return; }
        int dev = 0, cus = 0, per_cu = 0;
        if (hipGetDevice(&dev) != hipSuccess || hipDeviceGetAttribute(&cus, hipDeviceAttributeMultiprocessorCount, dev) != hipSuccess) { grid = -1; return; }
        if (hipFuncSetAttribute((const void*)fwd_kernel, hipFuncAttributeMaxDynamicSharedMemorySize, LDS_BYTES) != hipSuccess) { fprintf(stderr, "kernel_launch: hipFuncSetAttribute failed\n"); grid = -1; return; }
        if (hipOccupancyMaxActiveBlocksPerMultiprocessor(&per_cu, (const void*)fwd_kernel, NTHR, LDS_BYTES) != hipSuccess || per_cu < 1) fprintf(stderr, "kernel_launch: occupancy query reports %d\n", per_cu);
        (void)hipGetLastError();
        grid = cus;
    }
    if (grid < 0) return;
    if (hipMemsetAsync((char*)d_ws + WS_CTL, 0, CTL_BYTES, stream) != hipSuccess) { fprintf(stderr, "kernel_launch: memset failed\n"); return; }
    Args a{};
    for (int i = 0; i < 22; ++i) a.in[i] = (const float*)d_in[i];
    a.out = (float*)d_out; a.ws = (unsigned char*)d_ws;
    void* args[] = {&a};
    hipError_t e = hipLaunchCooperativeKernel((const void*)fwd_kernel, dim3(grid), dim3(NTHR), args, LDS_BYTES, stream);
    if (e != hipSuccess) fprintf(stderr, "kernel_launch: cooperative launch failed: %s\n", hipGetErrorString(e));
}
```
